# Optimizing an MI355X kernel written in HIP

```python
import math
import jax, jax.numpy as jnp
from jax import lax
import numpy as np

D_MODEL = 1024
BATCH = 16
SEQ = 2048
DEPTH = 2

N_MIXERS = 2
N_A_LAYERS = (DEPTH + 1) // 2
N_B_LAYERS = DEPTH // 2

S5_WIDTH = D_MODEL // 2
S5_GROUP = 16
S5_GROUPS = S5_WIDTH // S5_GROUP
S5_STATE = 64
DT_MIN = 0.001
DT_MAX = 0.1

SB_HEAD_DIM = 64
SB_HEADS = D_MODEL // SB_HEAD_DIM
Q_BLOCK = 128

D_FF = 7 * D_MODEL // 2
N_EXPERTS = 8
TOP_K = 2
NORM_EPS = 1e-6

kernel_name = "hybrid_s5_stickbreaking_moe_sandwich_adaln"


def rmsnorm(x, g):
    xf = x.astype(jnp.float32)
    xf = xf * lax.rsqrt(jnp.mean(xf * xf, axis=-1, keepdims=True) + NORM_EPS)
    return xf.astype(x.dtype) * g


def swiglu(h, w_gate_up, w_down):
    gate, up = jnp.split(h @ w_gate_up, 2, axis=-1)
    return (jax.nn.silu(gate) * up) @ w_down


def _complex_linear_combine(left, right):
    a1r, a1i, b1r, b1i = left
    a2r, a2i, b2r, b2i = right
    return (a2r * a1r - a2i * a1i,
            a2r * a1i + a2i * a1r,
            a2r * b1r - a2i * b1i + b2r,
            a2r * b1i + a2i * b1r + b2i)


def s5_mixer(h, w_in, lam_re, lam_im, b_re, b_im, c_re, c_im, d_skip, log_step, w_out):
    bsz, seq, _ = h.shape
    f32 = jnp.float32
    lam_re, lam_im = lam_re.astype(f32), lam_im.astype(f32)
    b_re, b_im = b_re.astype(f32), b_im.astype(f32)
    c_re, c_im = c_re.astype(f32), c_im.astype(f32)
    u = (h @ w_in).astype(f32).reshape(bsz, seq, S5_GROUPS, S5_GROUP)
    step = jnp.exp(log_step.astype(f32))[:, None]
    mag = jnp.exp(lam_re * step)
    lb_re = mag * jnp.cos(lam_im * step)
    lb_im = mag * jnp.sin(lam_im * step)
    den = lam_re * lam_re + lam_im * lam_im
    coef_re = ((lb_re - 1.0) * lam_re + lb_im * lam_im) / den
    coef_im = (lb_im * lam_re - (lb_re - 1.0) * lam_im) / den
    bb_re = coef_re[..., None] * b_re - coef_im[..., None] * b_im
    bb_im = coef_re[..., None] * b_im + coef_im[..., None] * b_re
    bu_re = jnp.einsum("blgh,gph->blgp", u, bb_re)
    bu_im = jnp.einsum("blgh,gph->blgp", u, bb_im)
    a_re = jnp.broadcast_to(lb_re, (1, seq) + lb_re.shape)
    a_im = jnp.broadcast_to(lb_im, (1, seq) + lb_im.shape)
    _, _, s_re, s_im = lax.associative_scan(
        _complex_linear_combine, (a_re, a_im, bu_re, bu_im), axis=1)
    y = (jnp.einsum("blgp,ghp->blgh", s_re, c_re)
         - jnp.einsum("blgp,ghp->blgh", s_im, c_im)
         + d_skip.astype(f32) * u)
    y = jax.nn.gelu(y.reshape(bsz, seq, S5_WIDTH)).astype(h.dtype)
    val, gate = jnp.split(y @ w_out, 2, axis=-1)
    return val * jax.nn.sigmoid(gate)


def stick_breaking_attention(h, w_qkv, w_out):
    bsz, seq, _ = h.shape
    qkv = (h @ w_qkv).reshape(bsz, seq, 3, SB_HEADS, SB_HEAD_DIM)
    q = jnp.transpose(qkv[:, :, 0], (0, 2, 1, 3))
    k = jnp.transpose(qkv[:, :, 1], (0, 2, 1, 3))
    v = jnp.transpose(qkv[:, :, 2], (0, 2, 1, 3))
    scale = 1.0 / math.sqrt(SB_HEAD_DIM)
    out_blocks = []
    for blk in range(seq // Q_BLOCK):
        t0 = blk * Q_BLOCK
        n_keys = t0 + Q_BLOCK
        z = jnp.einsum("bhqd,bhkd->bhqk", q[:, :, t0:n_keys],
                       k[:, :, :n_keys]).astype(jnp.float32) * scale
        t_pos = t0 + jnp.arange(Q_BLOCK)[:, None]
        s_pos = jnp.arange(n_keys)[None, :]
        strict = s_pos < t_pos
        log_keep = jnp.where(strict, jax.nn.log_sigmoid(-z), 0.0)
        log_keep_after = lax.cumsum(log_keep, axis=3, reverse=True) - log_keep
        weight = jnp.where(strict, jnp.exp(jax.nn.log_sigmoid(z) + log_keep_after), 0.0)
        out_blocks.append(jnp.einsum("bhqk,bhkd->bhqd", weight.astype(v.dtype),
                                     v[:, :, :n_keys]))
    o = jnp.concatenate(out_blocks, axis=2)
    o = jnp.transpose(o, (0, 2, 1, 3)).reshape(bsz, seq, D_MODEL)
    return o @ w_out


def moe_swiglu(h, w_router, b_router, w_gate_up, w_down):
    bsz, seq, d = h.shape
    tok = h.reshape(bsz * seq, d)
    logits = (tok @ w_router).astype(jnp.float32) + b_router.astype(jnp.float32)
    probs = jax.nn.softmax(logits, axis=-1)
    top_p, top_i = lax.top_k(probs, TOP_K)
    top_p = top_p / jnp.sum(top_p, axis=-1, keepdims=True)
    gates = jnp.sum(jax.nn.one_hot(top_i, N_EXPERTS, dtype=jnp.float32)
                    * top_p[..., None], axis=1)
    out = jnp.zeros_like(tok)
    for e in range(N_EXPERTS):
        out = out + gates[:, e:e + 1].astype(tok.dtype) * swiglu(tok, w_gate_up[e], w_down[e])
    return out.reshape(bsz, seq, d)


def setup_inputs(seed: int = 0) -> dict:
    key = jax.random.key(seed)
    ks = jax.random.split(key, 24)
    f32 = jnp.float32

    def nrm(k, shape, std):
        return std * jax.random.normal(k, shape, f32)

    d, w, g, p, hh = D_MODEL, S5_WIDTH, S5_GROUPS, S5_STATE, S5_GROUP
    return {
        "x": nrm(ks[0], (BATCH, SEQ, d), 1.0),
        "c": nrm(ks[1], (BATCH, d), 1.0),
        "ada_w": nrm(ks[2], (DEPTH, d, 6 * d), d ** -0.5),
        "ada_b": nrm(ks[3], (DEPTH, 6 * d), 0.02),
        "norm_g": 1.0 + nrm(ks[4], (DEPTH, 4, d), 0.02),
        "s5_w_in": nrm(ks[5], (N_A_LAYERS, d, w), d ** -0.5),
        "s5_lambda_re": -0.5 + nrm(ks[6], (N_A_LAYERS, g, p), 0.01),
        "s5_lambda_im": math.pi * jnp.arange(p, dtype=f32) + nrm(ks[7], (N_A_LAYERS, g, p), 0.01),
        "s5_b_re": nrm(ks[8], (N_A_LAYERS, g, p, hh), (2.0 * hh) ** -0.5),
        "s5_b_im": nrm(ks[9], (N_A_LAYERS, g, p, hh), (2.0 * hh) ** -0.5),
        "s5_c_re": nrm(ks[10], (N_A_LAYERS, g, hh, p), 0.5 ** 0.5),
        "s5_c_im": nrm(ks[11], (N_A_LAYERS, g, hh, p), 0.5 ** 0.5),
        "s5_d": nrm(ks[12], (N_A_LAYERS, g, hh), 1.0),
        "s5_log_step": jax.random.uniform(ks[13], (N_A_LAYERS, g), f32,
                                          math.log(DT_MIN), math.log(DT_MAX)),
        "s5_w_out": nrm(ks[14], (N_A_LAYERS, w, 2 * d), w ** -0.5),
        "sb_w_qkv": nrm(ks[15], (N_B_LAYERS, d, 3 * d), d ** -0.5),
        "sb_w_out": nrm(ks[16], (N_B_LAYERS, d, d), d ** -0.5),
        "ffn_w_gate_up": nrm(ks[17], (N_A_LAYERS, d, 2 * D_FF), d ** -0.5),
        "ffn_w_down": nrm(ks[18], (N_A_LAYERS, D_FF, d), D_FF ** -0.5),
        "moe_w_router": nrm(ks[19], (N_B_LAYERS, d, N_EXPERTS), d ** -0.5),
        "moe_b_router": nrm(ks[20], (N_B_LAYERS, N_EXPERTS), 0.01),
        "moe_w_gate_up": nrm(ks[21], (N_B_LAYERS, N_EXPERTS, d, 2 * D_FF), d ** -0.5),
        "moe_w_down": nrm(ks[22], (N_B_LAYERS, N_EXPERTS, D_FF, d), D_FF ** -0.5),
    }


def reference(x, c, ada_w, ada_b, norm_g, s5_w_in, s5_lambda_re, s5_lambda_im,
              s5_b_re, s5_b_im, s5_c_re, s5_c_im, s5_d, s5_log_step, s5_w_out,
              sb_w_qkv, sb_w_out, ffn_w_gate_up, ffn_w_down,
              moe_w_router, moe_b_router, moe_w_gate_up, moe_w_down):
    c_act = jax.nn.silu(c)
    for i in range(DEPTH):
        j = i // N_MIXERS
        mod = (c_act @ ada_w[i] + ada_b[i])[:, None, :]
        shift_m, scale_m, gate_m, shift_f, scale_f, gate_f = jnp.split(mod, 6, axis=-1)
        h = rmsnorm(x, norm_g[i, 0]) * (1.0 + scale_m) + shift_m
        if i % N_MIXERS == 0:
            y = s5_mixer(h, s5_w_in[j], s5_lambda_re[j], s5_lambda_im[j], s5_b_re[j],
                         s5_b_im[j], s5_c_re[j], s5_c_im[j], s5_d[j], s5_log_step[j],
                         s5_w_out[j])
        else:
            y = stick_breaking_attention(h, sb_w_qkv[j], sb_w_out[j])
        x = x + gate_m * rmsnorm(y, norm_g[i, 1])
        h = rmsnorm(x, norm_g[i, 2]) * (1.0 + scale_f) + shift_f
        if i % 2 == 0:
            y = swiglu(h, ffn_w_gate_up[j], ffn_w_down[j])
        else:
            y = moe_swiglu(h, moe_w_router[j], moe_b_router[j], moe_w_gate_up[j], moe_w_down[j])
        x = x + gate_f * rmsnorm(y, norm_g[i, 3])
    return x
```

```cpp
#include <hip/hip_runtime.h>
#include <cstdio>
#include <cstdint>

namespace pg8 {
#define PG8_LAS __attribute__((address_space(3)))
typedef unsigned short bf16_t;
typedef short bf16x8 __attribute__((ext_vector_type(8)));
typedef float f32x4 __attribute__((ext_vector_type(4)));
typedef float f32x2 __attribute__((ext_vector_type(2)));
typedef unsigned u32x4 __attribute__((ext_vector_type(4)));
constexpr int BM = 256, BK = 64, HALF = 128, HTB = HALF * BK * 2  , STAGE_BYTES = 8 * HTB, NXCD = 8, WGM = 8;
constexpr int PG8_RS_OFF = STAGE_BYTES + 2048;

__host__ __device__ __forceinline__ int lds_byte(int r, int c) { const int st = (r >> 4) * 2 + (c >> 5), rr = r & 15, cc = c & 31, ob = rr * 64 + cc * 2; return st * 1024 + (ob ^ (((ob >> 9) & 1) << 5)); }
__host__ __device__ __forceinline__ void stage_rc(int b, int& R, int& C) { const int st = b / 1024, sb = b % 1024, swz = sb ^ (((sb >> 9) & 1) << 5); R = (st >> 1) * 16 + swz / 64; C = (st & 1) * 32 + (swz % 64) / 2; }
__host__ __device__ __forceinline__ int perm32(int rho) { const int n = rho >> 4, i = rho & 15; return 8 * (i >> 2) + 4 * n + (i & 3); }

struct Unit { int pm, pn; const char* a; const char* b; int x; };
struct GemmG { int nt; int amode; int lda, ldb  , gm_rows; long kstepA, kstepB, hstepA, hstepB; int sw, sx;   const float* rowscale; float wscale;   };

__device__ __forceinline__ bool order_next(int nM, int nN, int G, int c, int i, int& pm, int& pn) {
    const int nwg = nM * nN; const long L = (long)i * G + c; if (L >= nwg) return false;
    int wgid = (int)L; { const int q = nwg / NXCD, r = nwg % NXCD, xcd = wgid % NXCD, off = wgid / NXCD; wgid = (xcd < r ? xcd * (q + 1) : r * (q + 1) + (xcd - r) * q) + off; }
    const int nig = WGM * nN, gid = wgid / nig, fm = gid * WGM, gsz = (nM - fm) < WGM ? (nM - fm) : WGM;
    pm = __builtin_amdgcn_readfirstlane(fm + ((wgid % nig) % gsz)); pn = __builtin_amdgcn_readfirstlane((wgid % nig) / gsz); return true;
}

__device__ __forceinline__ unsigned cvt_pk_bf16(float lo, float hi) { unsigned r; asm volatile("v_cvt_pk_bf16_f32 %0, %1, %2" : "=v"(r) : "v"(lo), "v"(hi)); return r; }
typedef int v8i __attribute__((ext_vector_type(8)));
typedef int v4i __attribute__((ext_vector_type(4)));
__device__ __forceinline__ float clamp8(float v) { return __builtin_amdgcn_fmed3f(v, -440.f, 440.f); }
__device__ __forceinline__ unsigned cvt4_fp8(float a, float b, float c, float d) { int w = 0; a = clamp8(a); b = clamp8(b); c = clamp8(c); d = clamp8(d); w = __builtin_amdgcn_cvt_pk_fp8_f32(a, b, w, false); w = __builtin_amdgcn_cvt_pk_fp8_f32(c, d, w, true); return (unsigned)w; }
__device__ __forceinline__ v8i cat8(bf16x8 a, bf16x8 b) { return __builtin_shufflevector(__builtin_bit_cast(v4i, a), __builtin_bit_cast(v4i, b), 0, 1, 2, 3, 4, 5, 6, 7); }
__device__ __forceinline__ float fsigmoid(float x) { return __builtin_amdgcn_rcpf(1.0f + __builtin_amdgcn_exp2f(-1.4426950408889634f * x)); }

struct EpiBf16 {
    static constexpr bool PERM = true, AFTER_DRAIN = false;
    bf16_t* O; int ldc; int split_cols; size_t split_stride; float scale0; float oscale = 1.f;
    __device__ __forceinline__ void operator()(const f32x4 (&acc)[2][2][4][2], const Unit& u, int wr, int wc, int fr, int fq) const {
        const int row0 = u.pm * BM + wr * 64 + fr; int colt = u.pn * BM; bf16_t* base = O;
        float sc = oscale; if (split_cols) { const int t = colt / split_cols; base += (size_t)t * split_stride; colt -= t * split_cols; if (t == 0) sc *= scale0; }
        const int col0 = colt + wc * 32 + 8 * fq;
#pragma unroll
        for (int ai = 0; ai < 2; ++ai)
#pragma unroll
            for (int m = 0; m < 4; ++m) { bf16_t* rowp = base + (size_t)(row0 + ai * HALF + m * 16) * ldc + col0;
#pragma unroll
                for (int bj = 0; bj < 2; ++bj) { f32x4 v0 = acc[ai][bj][m][0] * sc, v1 = acc[ai][bj][m][1] * sc;
                    u32x4 w; w.x = cvt_pk_bf16(v0[0], v0[1]); w.y = cvt_pk_bf16(v0[2], v0[3]); w.z = cvt_pk_bf16(v1[0], v1[1]); w.w = cvt_pk_bf16(v1[2], v1[3]);
                    *(u32x4*)(rowp + bj * HALF) = w; } }
    }
    __device__ __forceinline__ void i8(const f32x4 (&acc)[2][2][4][2], const Unit& u, int wr, int wc, int fr, int fq, const PG8_LAS float* rsl, float wscale) const {
        const int row0 = u.pm * BM + wr * 64 + fr; int colt = u.pn * BM; bf16_t* base = O;
        float sc = wscale; if (split_cols) { const int t = colt / split_cols; base += (size_t)t * split_stride; colt -= t * split_cols; if (t == 0) sc *= scale0; }
        const int col0 = colt + wc * 32 + 8 * fq;
#pragma unroll
        for (int ai = 0; ai < 2; ++ai)
#pragma unroll
            for (int m = 0; m < 4; ++m) { bf16_t* rowp = base + (size_t)(row0 + ai * HALF + m * 16) * ldc + col0; const float rs = rsl[ai * HALF + wr * 64 + m * 16 + fr] * sc;
#pragma unroll
                for (int bj = 0; bj < 2; ++bj) { float o[8];
#pragma unroll
                    for (int n = 0; n < 2; ++n)
#pragma unroll
                        for (int i = 0; i < 4; ++i) { const float fv = acc[ai][bj][m][n][i]; o[4 * n + i] = (float)__float_as_int(fv) * rs; }
                    u32x4 w; w.x = cvt_pk_bf16(o[0], o[1]); w.y = cvt_pk_bf16(o[2], o[3]); w.z = cvt_pk_bf16(o[4], o[5]); w.w = cvt_pk_bf16(o[6], o[7]);
                    *(u32x4*)(rowp + bj * HALF) = w; } }
    }
};
struct EpiF32Slab {
    static constexpr bool PERM = true, AFTER_DRAIN = false;
    float* S; float oscale;
    __device__ __forceinline__ void operator()(const f32x4 (&acc)[2][2][4][2], const Unit& u, int wr, int wc, int fr, int fq) const {
        const int row0 = (u.pm - 256) * BM + wr * 64 + fr, col0 = u.pn * BM + wc * 32 + 8 * fq; float* base = S + (size_t)u.x * (2048 * 1024);
#pragma unroll
        for (int ai = 0; ai < 2; ++ai)
#pragma unroll
            for (int m = 0; m < 4; ++m) { float* rowp = base + (size_t)(row0 + ai * HALF + m * 16) * 1024 + col0;
#pragma unroll
                for (int bj = 0; bj < 2; ++bj) { *(f32x4*)(rowp + bj * HALF) = acc[ai][bj][m][0] * oscale; *(f32x4*)(rowp + bj * HALF + 4) = acc[ai][bj][m][1] * oscale; } }
    }
};
template <int ACT, bool F8OUT = false> struct EpiGate {
    static constexpr bool PERM = true, AFTER_DRAIN = false;
    bf16_t* O; int ldc; float oscale;
    __device__ __forceinline__ void operator()(const f32x4 (&acc)[2][2][4][2], const Unit& u, int wr, int wc, int fr, int fq) const {
        const int row0 = u.pm * BM + wr * 64 + fr, col0 = u.pn * HALF + wc * 32 + 8 * fq;
#pragma unroll
        for (int ai = 0; ai < 2; ++ai)
#pragma unroll
            for (int m = 0; m < 4; ++m) { float o[8];
#pragma unroll
                for (int n = 0; n < 2; ++n)
#pragma unroll
                    for (int i = 0; i < 4; ++i) { const float a = acc[ai][0][m][n][i], b = acc[ai][1][m][n][i];
                        o[4 * n + i] = (ACT == 0) ? a * fsigmoid(b) : a * fsigmoid(a) * b; }
                if constexpr (F8OUT) { typedef unsigned u32x2 __attribute__((ext_vector_type(2))); u32x2 w; w.x = cvt4_fp8(o[0] * oscale, o[1] * oscale, o[2] * oscale, o[3] * oscale); w.y = cvt4_fp8(o[4] * oscale, o[5] * oscale, o[6] * oscale, o[7] * oscale);
                    __builtin_nontemporal_store(w, (u32x2*)((unsigned char*)O + (size_t)(row0 + ai * HALF + m * 16) * ldc + col0)); }
                else { u32x4 w; w.x = cvt_pk_bf16(o[0], o[1]); w.y = cvt_pk_bf16(o[2], o[3]); w.z = cvt_pk_bf16(o[4], o[5]); w.w = cvt_pk_bf16(o[6], o[7]);
                    __builtin_nontemporal_store(w, (u32x4*)(O + (size_t)(row0 + ai * HALF + m * 16) * ldc + col0)); } }
    }
    __device__ __forceinline__ void i8(const f32x4 (&acc)[2][2][4][2], const Unit& u, int wr, int wc, int fr, int fq, const PG8_LAS float* rsl, float wscale) const {
        static_assert(ACT == 1, "EpiGate::i8: SwiGLU only");
        const int row0 = u.pm * BM + wr * 64 + fr, col0 = u.pn * HALF + wc * 32 + 8 * fq;
#pragma unroll
        for (int ai = 0; ai < 2; ++ai)
#pragma unroll
            for (int m = 0; m < 4; ++m) { const float sr = rsl[ai * HALF + wr * 64 + m * 16 + fr] * wscale, c1 = -1.4426950408889634f * sr, c2 = sr * sr * oscale; float o[8];
#pragma unroll
                for (int n = 0; n < 2; ++n)
#pragma unroll
                    for (int i = 0; i < 4; ++i) { const float fa = acc[ai][0][m][n][i], fb = acc[ai][1][m][n][i]; const float ia = (float)__float_as_int(fa), ib = (float)__float_as_int(fb);
                        const float r = __builtin_amdgcn_rcpf(1.0f + __builtin_amdgcn_exp2f(ia * c1)); o[4 * n + i] = (ia * ib) * (c2 * r); }
                if constexpr (F8OUT) { typedef unsigned u32x2 __attribute__((ext_vector_type(2))); u32x2 w; w.x = cvt4_fp8(o[0], o[1], o[2], o[3]); w.y = cvt4_fp8(o[4], o[5], o[6], o[7]);
                    __builtin_nontemporal_store(w, (u32x2*)((unsigned char*)O + (size_t)(row0 + ai * HALF + m * 16) * ldc + col0)); }
                else { u32x4 w; w.x = cvt_pk_bf16(o[0], o[1]); w.y = cvt_pk_bf16(o[2], o[3]); w.z = cvt_pk_bf16(o[4], o[5]); w.w = cvt_pk_bf16(o[6], o[7]);
                    __builtin_nontemporal_store(w, (u32x4*)(O + (size_t)(row0 + ai * HALF + m * 16) * ldc + col0)); } }
    }
};
struct EpiS5U {
    static constexpr bool PERM = true, AFTER_DRAIN = false;
    bf16_t* UA;
    __device__ __forceinline__ void operator()(const f32x4 (&acc)[2][2][4][2], const Unit& u, int wr, int wc, int fr, int fq) const {
#pragma unroll
        for (int ai = 0; ai < 2; ++ai)
#pragma unroll
            for (int m = 0; m < 4; ++m) { const int tok = u.pm * BM + ai * HALF + wr * 64 + m * 16 + fr, b = tok >> 11, t = tok & 2047, c = t >> 5, k = t & 31;
#pragma unroll
                for (int bj = 0; bj < 2; ++bj) { const int g = u.pn * 16 + bj * 8 + wc * 2 + (fq >> 1), h0 = (fq & 1) * 8;
                    const f32x4 v0 = acc[ai][bj][m][0], v1 = acc[ai][bj][m][1];
                    u32x4 w; w.x = cvt_pk_bf16(v0[0], v0[1]); w.y = cvt_pk_bf16(v0[2], v0[3]); w.z = cvt_pk_bf16(v1[0], v1[1]); w.w = cvt_pk_bf16(v1[2], v1[3]);
                    *(u32x4*)(UA + ((size_t)(g * 1024 + b * 64 + c) * 640 + k * 16 + h0)) = w; } }
    }
};
struct EpiS5Scan {
    static constexpr bool PERM = false, AFTER_DRAIN = true;
    bf16_t* UA; const float* lamT;
    __device__ __forceinline__ void fused(f32x4 (&acc)[2][2][4][2], const Unit& u, int wr, int wc, int fr, int fq, PG8_LAS unsigned char* lds, int wid, int lane) const {
        PG8_LAS float* S = (PG8_LAS float*)lds;
#pragma unroll
        for (int ai = 0; ai < 2; ++ai)
#pragma unroll
            for (int m = 0; m < 4; ++m)
#pragma unroll
                for (int n = 0; n < 2; ++n) { const int r = ai * HALF + wr * 64 + m * 16 + fr, c = wc * 32 + 16 * n + 4 * fq;
                    *(PG8_LAS f32x4*)(S + r * 128 + c) = acc[ai][0][m][n]; }
        asm volatile("s_waitcnt lgkmcnt(0)" ::: "memory"); __builtin_amdgcn_s_barrier(); asm volatile("" ::: "memory");
        if (wid < 4) {
        const int g = u.x, bl = wid, p = lane;
        const float lr = lamT[(g * 64 + p) * 2], li = lamT[(g * 64 + p) * 2 + 1];
        float sr = 0.f, si = 0.f;
        bf16_t* dst = UA + ((size_t)(g * 1024 + (u.pm * 4 + bl) * 64) * 640 + 512 + p);
        for (int c = 0; c < 64; ++c) {
            const float ar = S[(bl * 64 + c) * 128 + p], aim = S[(bl * 64 + c) * 128 + 64 + p];
            const unsigned pk = cvt_pk_bf16(sr, si);
            dst[(size_t)c * 640] = (bf16_t)(pk & 0xffffu); dst[(size_t)c * 640 + 64] = (bf16_t)(pk >> 16);
            const float nr = lr * sr - li * si + ar, ni = lr * si + li * sr + aim; sr = nr; si = ni;
        } }
    }
};
struct EpiS5Y {
    static constexpr bool PERM = true, AFTER_DRAIN = false;
    bf16_t* Yg;
    __device__ __forceinline__ void operator()(const f32x4 (&acc)[2][2][4][2], const Unit& u, int wr, int wc, int fr, int fq) const {
        const int g = u.x;
#pragma unroll
        for (int ai = 0; ai < 2; ++ai)
#pragma unroll
            for (int m = 0; m < 4; ++m) { const int r = ai * HALF + wr * 64 + m * 16 + fr, b = u.pm * 4 + (r >> 6), c = r & 63;
#pragma unroll
                for (int bj = 0; bj < 2; ++bj) { const int tau = u.pn * 16 + bj * 8 + wc * 2 + (fq >> 1), tok = b * 2048 + c * 32 + tau; float o[8];
#pragma unroll
                    for (int n = 0; n < 2; ++n)
#pragma unroll
                        for (int i = 0; i < 4; ++i) { const float x = acc[ai][bj][m][n][i]; o[4 * n + i] = x * fsigmoid(1.5957691216057308f * (x + 0.044715f * x * x * x)); }
                    u32x4 w; w.x = cvt_pk_bf16(o[0], o[1]); w.y = cvt_pk_bf16(o[2], o[3]); w.z = cvt_pk_bf16(o[4], o[5]); w.w = cvt_pk_bf16(o[6], o[7]);
                    *(u32x4*)(Yg + ((size_t)(g * 32768 + tok) * 16 + (fq & 1) * 8)) = w; } }
    }
};

template <class Epi, class Sched, bool ALIGN_EPI = false, bool SP2 = false, int MODE = 0  >
__device__ __forceinline__ void gemm_phase(PG8_LAS unsigned char* lds, const GemmG g, const Sched& S, const Epi& E) {
    const int tid = threadIdx.x, wid = __builtin_amdgcn_readfirstlane(tid >> 6), lane = tid & 63, wr = wid >> 2, wc = wid & 3, fr = lane & 15, fq = lane >> 4;
    constexpr bool FP8 = (MODE == 1), I8 = (MODE == 2);
    const int nt = g.nt; const int sclw = g.sw, sclx = g.sx;
    unsigned voffA[2], voffB[2];
#pragma unroll
    for (int i = 0; i < 2; ++i) { int R, C; stage_rc(tid * 16 + i * 8192, R, C); const int Rb = Epi::PERM ? ((R & ~31) + perm32(R & 31)) : R;
        voffA[i] = g.amode == 0 ? (unsigned)(R * g.lda + C * 2) : (unsigned)(((C >> 4) * g.gm_rows + R) * 32 + (C & 15) * 2); voffB[i] = (unsigned)(Rb * g.ldb + C * 2); }
    const long kstepA = g.kstepA, kstepB = g.kstepB, hstepA = g.hstepA, hstepB = g.hstepB;
    const unsigned ldsw = (unsigned)wid * 1024u;
    const int aoff = lds_byte(wr * 64 + fr, fq * 8), boff = lds_byte(wc * 32 + fr, fq * 8);
#define PG8_SA(b, h) (((b) * 2 + (h)) * HTB)
#define PG8_SB(b, h) ((4 + (b) * 2 + (h)) * HTB)
#define PG8_STAGE(bufoff, gbase, voff) do { _Pragma("unroll") for (int _i = 0; _i < 2; ++_i) \
        __builtin_amdgcn_global_load_lds((const unsigned*)((const char*)(gbase) + (voff)[_i]), (PG8_LAS unsigned*)(lds + (bufoff) + ldsw + _i * 8192), 16, 0, 0); } while (0)
#define PG8_LDA(dst, b, h) do { if constexpr (FP8) { _Pragma("unroll") for (int m = 0; m < 4; ++m) dst##8[m] = cat8(*(const PG8_LAS bf16x8*)(lds + PG8_SA(b, h) + aoff + m * 2048), *(const PG8_LAS bf16x8*)(lds + PG8_SA(b, h) + aoff + m * 2048 + 1024)); } \
        else { _Pragma("unroll") for (int m = 0; m < 4; ++m) _Pragma("unroll") for (int k = 0; k < 2; ++k) dst[m][k] = *(const PG8_LAS bf16x8*)(lds + PG8_SA(b, h) + aoff + m * 2048 + k * 1024); } } while (0)
#define PG8_LDB(dst, b, h) do { if constexpr (FP8) { _Pragma("unroll") for (int n = 0; n < 2; ++n) dst##8[n] = cat8(*(const PG8_LAS bf16x8*)(lds + PG8_SB(b, h) + boff + n * 2048), *(const PG8_LAS bf16x8*)(lds + PG8_SB(b, h) + boff + n * 2048 + 1024)); } \
        else { _Pragma("unroll") for (int n = 0; n < 2; ++n) _Pragma("unroll") for (int k = 0; k < 2; ++k) dst[n][k] = *(const PG8_LAS bf16x8*)(lds + PG8_SB(b, h) + boff + n * 2048 + k * 1024); } } while (0)
#define PG8_MMA(ai, bj, At, Bt) do { __builtin_amdgcn_s_setprio(1); if constexpr (FP8) { _Pragma("unroll") for (int m = 0; m < 4; ++m) _Pragma("unroll") for (int n = 0; n < 2; ++n) \
        asm volatile("v_mfma_f32_16x16x128_f8f6f4 %0, %1, %2, %0" : "+v"(acc[ai][bj][m][n]) : "v"(Bt##8[n]), "v"(At##8[m])); } else { \
        _Pragma("unroll") for (int m = 0; m < 4; ++m) _Pragma("unroll") for (int n = 0; n < 2; ++n) _Pragma("unroll") for (int k = 0; k < 2; ++k) { \
        if constexpr (I8) acc[ai][bj][m][n] = __builtin_bit_cast(f32x4, __builtin_amdgcn_mfma_i32_16x16x64_i8(__builtin_bit_cast(v4i, Bt[n][k]), __builtin_bit_cast(v4i, At[m][k]), __builtin_bit_cast(v4i, acc[ai][bj][m][n]), 0, 0, 0)); \
        else acc[ai][bj][m][n] = __builtin_amdgcn_mfma_f32_16x16x32_bf16(Bt[n][k], At[m][k], acc[ai][bj][m][n], 0, 0, 0); } } __builtin_amdgcn_s_setprio(0); } while (0)
#define PG8_WAIT_V(n) asm volatile("s_waitcnt vmcnt(" #n ")" ::: "memory")
#define PG8_WAIT_L(n) asm volatile("s_waitcnt lgkmcnt(" #n ")" ::: "memory")
#define PG8_BAR __builtin_amdgcn_s_barrier()
#define PG8_SCHED __builtin_amdgcn_sched_barrier(0)
    Unit cur, nxt; int ui = 0;
    if (!S.next(0, cur)) return;
    f32x4 acc[2][2][4][2];
#pragma unroll
    for (int a = 0; a < 2; ++a)
#pragma unroll
        for (int b = 0; b < 2; ++b)
#pragma unroll
            for (int m = 0; m < 4; ++m)
#pragma unroll
                for (int n = 0; n < 2; ++n) acc[a][b][m][n] = (f32x4){0.f, 0.f, 0.f, 0.f};
    bf16x8 At[4][2], B0[2][2], B1[2][2]; v8i At8[4], B08[2], B18[2];
    const char* cA = cur.a; const char* cB = cur.b;
#define PG8_RS_LOAD(u_, par_) do { if constexpr (I8) { if (wid == 0) __builtin_amdgcn_global_load_lds((const unsigned*)(g.rowscale + (size_t)(u_).pm * BM + lane * 4), (PG8_LAS unsigned*)(lds + PG8_RS_OFF + (par_) * 1024), 16, 0, 0); } } while (0)
    PG8_RS_LOAD(cur, 0);
    if constexpr (SP2) {
        PG8_STAGE(PG8_SB(0, 0), cB, voffB); PG8_STAGE(PG8_SB(0, 1), cB + hstepB, voffB); PG8_STAGE(PG8_SA(0, 0), cA, voffA); PG8_STAGE(PG8_SA(0, 1), cA + hstepA, voffA);
        if (wr == 1) PG8_BAR;
        PG8_WAIT_V(2); PG8_BAR;
        PG8_STAGE(PG8_SB(1, 0), cB + kstepB, voffB); PG8_STAGE(PG8_SA(1, 0), cA + kstepA, voffA); PG8_STAGE(PG8_SB(1, 1), cB + hstepB + kstepB, voffB);
        PG8_WAIT_V(6); PG8_BAR;
    } else {
        PG8_STAGE(PG8_SB(0, 0), cB, voffB); PG8_STAGE(PG8_SA(0, 0), cA, voffA); PG8_STAGE(PG8_SB(0, 1), cB + hstepB, voffB); PG8_STAGE(PG8_SA(0, 1), cA + hstepA, voffA);
        if (wr == 1) PG8_BAR;
        PG8_WAIT_V(4); PG8_BAR;
        PG8_STAGE(PG8_SB(1, 0), cB + kstepB, voffB); PG8_STAGE(PG8_SA(1, 0), cA + kstepA, voffA); PG8_STAGE(PG8_SB(1, 1), cB + hstepB + kstepB, voffB);
        PG8_WAIT_V(6); PG8_BAR;
    }
    for (;;) {
        const bool has_next = S.next(ui + 1, nxt);
        const char* nA = has_next ? nxt.a : cA; const char* nB = has_next ? nxt.b : cB;
#pragma unroll 1
        for (int t = 0; t < nt; t += 2) {
            const bool last = (t == nt - 2);
            const char* a1 = cA + (long)(t + 1) * kstepA;
            const char* a2 = last ? nA : cA + (long)(t + 2) * kstepA; const char* b2 = last ? nB : cB + (long)(t + 2) * kstepB;
            const char* a3 = a2 + kstepA; const char* b3 = b2 + kstepB;
            if constexpr (SP2) {
            PG8_LDB(B0, 0, 0); PG8_LDB(B1, 0, 1); PG8_SCHED; PG8_LDA(At, 0, 0); PG8_STAGE(PG8_SA(1, 1), a1 + hstepA, voffA);
            PG8_WAIT_V(8); PG8_WAIT_L(0); PG8_BAR; PG8_MMA(0, 0, At, B0); PG8_MMA(0, 1, At, B1); PG8_BAR; PG8_SCHED;
            PG8_LDA(At, 0, 1); PG8_STAGE(PG8_SB(0, 0), b2, voffB); PG8_STAGE(PG8_SB(0, 1), b2 + hstepB, voffB); PG8_STAGE(PG8_SA(0, 0), a2, voffA);
            PG8_WAIT_V(8); PG8_WAIT_L(0); PG8_BAR; PG8_MMA(1, 0, At, B0); PG8_MMA(1, 1, At, B1); PG8_BAR; PG8_SCHED;
            PG8_LDB(B0, 1, 0); PG8_LDB(B1, 1, 1); PG8_SCHED; PG8_LDA(At, 1, 0); PG8_STAGE(PG8_SA(0, 1), a2 + hstepA, voffA);
            PG8_WAIT_V(8); PG8_WAIT_L(0); PG8_BAR; PG8_MMA(0, 0, At, B0); PG8_MMA(0, 1, At, B1); PG8_BAR; PG8_SCHED;
            PG8_LDA(At, 1, 1); PG8_STAGE(PG8_SB(1, 0), b3, voffB); PG8_STAGE(PG8_SB(1, 1), b3 + hstepB, voffB); PG8_STAGE(PG8_SA(1, 0), a3, voffA);
            PG8_WAIT_V(8); PG8_WAIT_L(0); PG8_BAR; PG8_MMA(1, 0, At, B0); PG8_MMA(1, 1, At, B1); PG8_BAR; PG8_SCHED;
            } else {
            PG8_LDB(B0, 0, 0); PG8_SCHED; PG8_LDA(At, 0, 0); PG8_STAGE(PG8_SA(1, 1), a1 + hstepA, voffA);
            PG8_WAIT_L(8); PG8_BAR; PG8_WAIT_L(0); PG8_MMA(0, 0, At, B0); PG8_BAR; PG8_SCHED;
            PG8_LDB(B1, 0, 1); PG8_STAGE(PG8_SB(0, 0), b2, voffB);
            PG8_BAR; PG8_WAIT_L(0); PG8_MMA(0, 1, At, B1); PG8_BAR;
            PG8_LDA(At, 0, 1); PG8_STAGE(PG8_SA(0, 0), a2, voffA);
            PG8_BAR; PG8_WAIT_L(0); PG8_MMA(1, 0, At, B0); PG8_BAR; PG8_SCHED;
            PG8_STAGE(PG8_SB(0, 1), b2 + hstepB, voffB);
            PG8_WAIT_V(6); PG8_BAR; PG8_MMA(1, 1, At, B1); PG8_BAR;
            PG8_LDB(B0, 1, 0); PG8_SCHED; PG8_LDA(At, 1, 0); PG8_STAGE(PG8_SA(0, 1), a2 + hstepA, voffA);
            PG8_WAIT_L(8); PG8_BAR; PG8_WAIT_L(0); PG8_MMA(0, 0, At, B0); PG8_BAR; PG8_SCHED;
            PG8_LDB(B1, 1, 1); PG8_STAGE(PG8_SB(1, 0), b3, voffB);
            PG8_BAR; PG8_WAIT_L(0); PG8_MMA(0, 1, At, B1); PG8_BAR;
            PG8_LDA(At, 1, 1); PG8_STAGE(PG8_SA(1, 0), a3, voffA);
            PG8_BAR; PG8_WAIT_L(0); PG8_MMA(1, 0, At, B0); PG8_BAR; PG8_SCHED;
            PG8_STAGE(PG8_SB(1, 1), b3 + hstepB, voffB);
            PG8_WAIT_V(6); PG8_BAR; PG8_MMA(1, 1, At, B1); PG8_BAR;
            }
        }
        if constexpr (ALIGN_EPI) { if (wr == 0) PG8_BAR; }
        if constexpr (FP8) { PG8_SCHED; asm volatile("s_nop 15\n\ts_nop 15" ::: "memory"); PG8_SCHED; }
        if constexpr (I8) { E.i8(acc, cur, wr, wc, fr, fq, (const PG8_LAS float*)(lds + PG8_RS_OFF + (ui & 1) * 1024), g.wscale); }
        else if constexpr (!Epi::AFTER_DRAIN) { E(acc, cur, wr, wc, fr, fq); }
        if (!has_next) break;
#pragma unroll
        for (int a = 0; a < 2; ++a)
#pragma unroll
            for (int b = 0; b < 2; ++b)
#pragma unroll
                for (int m = 0; m < 4; ++m)
#pragma unroll
                    for (int n = 0; n < 2; ++n) acc[a][b][m][n] = (f32x4){0.f, 0.f, 0.f, 0.f};
        cur = nxt; cA = nA; cB = nB; ++ui;
        PG8_RS_LOAD(cur, ui & 1);
        if constexpr (ALIGN_EPI) { if (wr == 1) PG8_BAR; }
    }
    PG8_WAIT_V(0);
    if constexpr (!ALIGN_EPI) { if (wr == 0) PG8_BAR; }
    PG8_BAR;
    if constexpr (Epi::AFTER_DRAIN) { E.fused(acc, cur, wr, wc, fr, fq, lds, wid, lane); }
#undef PG8_RS_LOAD
#undef PG8_SA
#undef PG8_SB
#undef PG8_STAGE
#undef PG8_LDA
#undef PG8_LDB
#undef PG8_MMA
#undef PG8_WAIT_V
#undef PG8_WAIT_L
#undef PG8_BAR
#undef PG8_SCHED
}
}

constexpr int NWAVES = 8;
constexpr int BATCH = 16, SEQ = 2048, DM = 1024, MTOK = BATCH * SEQ;
constexpr int S5G = 32, TC = 32, NCH = SEQ / TC;
constexpr int NHEAD = 16, HD = 64, FF = 3584, NE = 8;
constexpr int NPH = 18;
#ifndef MK_N_LAUNCHES
#define MK_N_LAUNCHES 1
#endif
constexpr int N_LAUNCHES = MK_N_LAUNCHES;
constexpr float NORM_EPS = 1e-6f;
constexpr float W8_CLIP = 5.0f / 32.0f, W8_Q = 127.0f / W8_CLIP, W8_DQ = W8_CLIP / 127.0f;
constexpr float C2 = 0.125f * 1.4426950408889634f;

constexpr size_t MiB = 1u << 20;
constexpr size_t WS_CTL = 0, CTL_ZERO_BYTES = 32768;
constexpr size_t WS_MOD = 1 * MiB;
constexpr size_t WS_RT = 2 * MiB;
constexpr size_t WS_SH = 3 * MiB, WS_SX = 3 * MiB + 256 * 1024;
constexpr size_t RT_E = 0, RT_G = 128 * 1024, RT_SLOT = 256 * 1024, RT_CNT = 512 * 1024, RT_LAMT = 640 * 1024, RT_TS = 700 * 1024;
constexpr size_t WS_WIN = 4 * MiB, WS_WOUT = 5 * MiB, WS_WGU = 7 * MiB, WS_WD = 21 * MiB, WS_WQKV = 28 * MiB, WS_WO = 34 * MiB, WS_MWGU = 36 * MiB, WS_MWD = 148 * MiB;
constexpr size_t WS_W1 = 204 * MiB, WS_KTAB = 212 * MiB;
constexpr size_t WS_XP = 214 * MiB;
constexpr size_t WS_TW = 214 * MiB, WS_UA = 240 * MiB;
constexpr size_t WS_ACTM = 346 * MiB;
constexpr size_t WS_H = 346 * MiB, WS_YB = 410 * MiB, WS_YG = 474 * MiB, WS_ACT = 474 * MiB, WS_Q = 474 * MiB, WS_K = 538 * MiB, WS_V = 602 * MiB;
constexpr size_t WS_SLAB = 214 * MiB;
constexpr size_t WS_YS = 600 * MiB;
constexpr size_t WS_XR = 736 * MiB;
constexpr size_t WS_END = 808 * MiB;
constexpr int XP_ROWS = 67584;
static_assert(WS_XP + (size_t)XP_ROWS * DM <= WS_ACTM && WS_ACTM + (size_t)XP_ROWS * FF <= WS_YS && WS_YS + (size_t)XP_ROWS * DM * 2 <= WS_END, "ws map");
constexpr int CW_TMO = 0, CW_CODE = 1, CW_P0CTR = 64, CW_ATTCTR = 2048, CW_BAR = 4096;
static_assert((CW_BAR + 3456) * 4 <= (int)CTL_ZERO_BYTES && CTL_ZERO_BYTES % 16 == 0, "control words inside the per-call memset");

constexpr int RING_OFF = 0, RING_BYTES = 131072;
constexpr int LDSCTL_OFF = RING_BYTES, MISC_OFF = LDSCTL_OFF + 320;
constexpr int LDS_BYTES = 147456;

#define GAS __attribute__((address_space(1)))
#define LAS __attribute__((address_space(3)))
typedef unsigned short bf16;
typedef unsigned v4u __attribute__((ext_vector_type(4)));
typedef unsigned v2u __attribute__((ext_vector_type(2)));
typedef float f32x4 __attribute__((ext_vector_type(4)));
typedef float f32x16 __attribute__((ext_vector_type(16)));
typedef short bf16x8 __attribute__((ext_vector_type(8)));
typedef short s16x4 __attribute__((ext_vector_type(4)));
typedef GAS unsigned gu32;
#define RLX_AGENT __ATOMIC_RELAXED, __HIP_MEMORY_SCOPE_AGENT
#define LDS_WAIT() asm volatile("s_waitcnt lgkmcnt(0)" ::: "memory")
#define VM_WAIT() asm volatile("s_waitcnt vmcnt(0)" ::: "memory")
__device__ __forceinline__ unsigned f2bf(float f) { unsigned u = __builtin_bit_cast(unsigned, f); return (u + 0x7fffu + ((u >> 16) & 1u)) >> 16; }
__device__ __forceinline__ unsigned pk2(float lo, float hi) { return f2bf(lo) | (f2bf(hi) << 16); }
__device__ __forceinline__ float bf_lo(unsigned w) { return __builtin_bit_cast(float, w << 16); }
__device__ __forceinline__ float bf_hi(unsigned w) { return __builtin_bit_cast(float, w & 0xffff0000u); }

#define XB_TMO      128
#define XB_XCNT(j)  (256  + 64 * (j))
#define XB_XSUB(j)  (1280 + 64 * (j))
#define XB_XGEN(j)  (2304 + 64 * (j))
#define XB_TOP      3328
#define XB_TOPGEN   3392
#define XCD_BAR_WORDS 3456
#define XB_SPIN_CAP (1u << 18)

__device__ __forceinline__ unsigned xb_ld(unsigned* p)              { return __hip_atomic_load(p, __ATOMIC_RELAXED, __HIP_MEMORY_SCOPE_AGENT); }
__device__ __forceinline__ unsigned xb_add(unsigned* p, unsigned v) { return __hip_atomic_fetch_add(p, v, __ATOMIC_RELAXED, __HIP_MEMORY_SCOPE_AGENT); }
__device__ __forceinline__ unsigned xb_xcc_id() { return (unsigned)__builtin_amdgcn_s_getreg((3 << 11) | 20) & 0xFu; }
#define XB_SPIN(cond, bar) do { unsigned _sp = 0; while (cond) { __builtin_amdgcn_s_sleep(1); \
    if ((++_sp & 255u) == 0u) { if (xb_ld(&(bar)[XB_TMO])) break; if (_sp > XB_SPIN_CAP) { atomicAdd(&(bar)[XB_TMO], 1u); break; } } } } while (0)

struct XcdBarrier {
    unsigned* bar; unsigned x;
    volatile LAS unsigned* st;
};

__device__ __forceinline__ XcdBarrier xcd_barrier_post(unsigned* bar, volatile LAS unsigned* st) {
    XcdBarrier b; b.bar = bar; b.x = xb_xcc_id(); b.st = st;
    if (threadIdx.x == 0) (void)xb_add(&bar[XB_XCNT(b.x)], 1u);
    return b;
}
__device__ __forceinline__ void xcd_barrier_complete(unsigned* bar, unsigned x, unsigned& nloc, unsigned& nx) {
    const unsigned G = gridDim.x * gridDim.y * gridDim.z;
    unsigned sum, cnt, mine, sp = 0u;
    for (;;) {
        sum = 0u; cnt = 0u; mine = 0u;
#pragma unroll
        for (unsigned j = 0; j < 16; ++j) { const unsigned c = xb_ld(&bar[XB_XCNT(j)]); sum += c; cnt += (c > 0u) ? 1u : 0u; mine = (j == x) ? c : mine; }
        if (sum == G) break;
        __builtin_amdgcn_s_sleep(1);
        if ((++sp & 255u) == 0u) { if (xb_ld(&bar[XB_TMO])) break; if (sp > XB_SPIN_CAP) { atomicAdd(&bar[XB_TMO], 1u); break; } }
    }
    nloc = mine > 0u ? mine : 1u; nx = cnt > 0u ? cnt : 1u;
}

__device__ __forceinline__ void xcd_barrier(const XcdBarrier& b) {
    asm volatile("s_waitcnt vmcnt(0)" ::: "memory");
    __syncthreads();
    if (threadIdx.x == 0) {
        unsigned* bar = b.bar;
        __builtin_amdgcn_s_waitcnt(0);
        unsigned nloc = b.st[0], nx = b.st[1];
        if (nloc == 0u) { xcd_barrier_complete(bar, b.x, nloc, nx); b.st[0] = nloc; b.st[1] = nx; }
        const unsigned old = xb_add(&bar[XB_XSUB(b.x)], 1u);
        const unsigned gen = old / nloc;
        if (old + 1u == (gen + 1u) * nloc) {
            __builtin_amdgcn_fence(__ATOMIC_RELEASE, "agent");
            asm volatile("s_waitcnt vmcnt(0)" ::: "memory");
            const unsigned og = xb_add(&bar[XB_TOP], 1u);
            const unsigned tg = og / nx;
            if (og + 1u == (tg + 1u) * nx) xb_add(&bar[XB_TOPGEN], 1u);
            else XB_SPIN(xb_ld(&bar[XB_TOPGEN]) == tg, bar);
            __builtin_amdgcn_fence(__ATOMIC_ACQUIRE, "agent");
            xb_add(&bar[XB_XGEN(b.x)], 1u);
            asm volatile("s_waitcnt vmcnt(0)" ::: "memory");
        } else {
            XB_SPIN(xb_ld(&bar[XB_XGEN(b.x)]) == gen, bar);
            __builtin_amdgcn_fence(__ATOMIC_ACQUIRE, "agent");
            asm volatile("s_waitcnt vmcnt(0)" ::: "memory");
        }
    }
    __syncthreads();
}

namespace sba {
constexpr int NW = 8, QBLK = 32, QB = 256, KVBLK = 64, SLOTB = 8192;
constexpr float SBA_EXIT_MASS = 0x1p-48f;
constexpr int NSLOT = 4, LDS_K = 0, LDS_V = NSLOT * SLOTB, LDS_OST = 2 * NSLOT * SLOTB, LDS_FIN = LDS_OST + NW * 4096, LDS_BYTES = LDS_FIN + 16;
typedef __attribute__((address_space(3))) const char* lds_cptr;
typedef short v4i16_t __attribute__((ext_vector_type(4)));
__device__ __forceinline__ void glds16(const void* gsrc, unsigned lds_dst) { unsigned keep;
    asm volatile("s_mov_b32 %0, m0\n\ts_mov_b32 m0, %2\n\ts_nop 0\n\tglobal_load_lds_dwordx4 %1, off\n\ts_mov_b32 m0, %0" : "=&s"(keep) : "v"(gsrc), "s"(lds_dst) : "memory"); }
__device__ __forceinline__ s16x4 vtr(lds_cptr p) { return __builtin_bit_cast(s16x4, __builtin_amdgcn_ds_read_tr16_b64_v4i16((__attribute__((address_space(3))) v4i16_t*)p)); }
__device__ __forceinline__ unsigned cvtpk(float lo, float hi) { typedef float f2 __attribute__((ext_vector_type(2))); typedef __bf16 b2 __attribute__((ext_vector_type(2))); f2 v = {lo, hi}; b2 b = __builtin_convertvector(v, b2); return __builtin_bit_cast(unsigned, b); }
__device__ __forceinline__ int crow(int r, int hi) { return (r & 3) + 8 * (r >> 2) + 4 * hi; }

template <bool MASK> __device__ __forceinline__ void tile(f32x16 (&o)[2], float& Cc, const bf16x8 (&qr)[4], lds_cptr kp, lds_cptr vp, int kq, int hi, bool skip_hi_block) {
    f32x16 p0 = {}, p1 = {};
#pragma unroll
    for (int d0 = 0; d0 < 4; ++d0) {
        const bf16x8 b0 = *(const __attribute__((address_space(3))) bf16x8*)(kp + d0 * 2048);
        const bf16x8 b1 = *(const __attribute__((address_space(3))) bf16x8*)(kp + d0 * 2048 + 512);
        p0 = __builtin_amdgcn_mfma_f32_32x32x16_bf16(b0, qr[d0], p0, 0, 0, 0);
        if (!(MASK && skip_hi_block)) p1 = __builtin_amdgcn_mfma_f32_32x32x16_bf16(b1, qr[d0], p1, 0, 0, 0);
    }
#define SBA_PV(P, kb) do { _Pragma("unroll") for (int s = 0; s < 2; ++s) { v4u pw; pw.x = cvtpk(P[8 * s], P[8 * s + 1]); pw.y = cvtpk(P[8 * s + 2], P[8 * s + 3]); pw.z = cvtpk(P[8 * s + 4], P[8 * s + 5]); pw.w = cvtpk(P[8 * s + 6], P[8 * s + 7]); \
        const bf16x8 pa = __builtin_bit_cast(bf16x8, pw); _Pragma("unroll") for (int d0 = 0; d0 < 2; ++d0) { \
            const s16x4 lo = vtr(vp + d0 * 4096 + (kb) * 2048 + s * 512), hv = vtr(vp + d0 * 4096 + (kb) * 2048 + s * 512 + 256); \
            const bf16x8 vf = (bf16x8){lo[0], lo[1], lo[2], lo[3], hv[0], hv[1], hv[2], hv[3]}; \
            o[d0] = __builtin_amdgcn_mfma_f32_32x32x16_bf16(pa, vf, o[d0], 0, 0, 0); } } } while (0)
    if (!(MASK && skip_hi_block)) {
        float a1 = 1.f;
#pragma unroll
        for (int r = 15; r >= 0; --r) { float rr = __builtin_amdgcn_rcpf(1.0f + __builtin_amdgcn_exp2f(p1[r])); if (MASK) rr = (kq + 32 + r < 0) ? rr : 1.0f; const float n = a1 * rr; p1[r] = a1 - n; a1 = n; }
        const auto s1 = __builtin_amdgcn_permlane32_swap(__float_as_uint(a1), __float_as_uint(a1), false, false);
        const float a1lo = __uint_as_float(s1[0]), a1hi = __uint_as_float(s1[1]);
        const float base1 = hi ? Cc : Cc * a1hi;
        Cc = Cc * a1hi * a1lo;
#pragma unroll
        for (int r = 0; r < 16; ++r) p1[r] *= base1;
        SBA_PV(p1, 1);
        if (__all(Cc < SBA_EXIT_MASS)) return;
    }
    {
        float a0 = 1.f;
#pragma unroll
        for (int r = 15; r >= 0; --r) { float rr = __builtin_amdgcn_rcpf(1.0f + __builtin_amdgcn_exp2f(p0[r])); if (MASK) rr = (kq + r < 0) ? rr : 1.0f; const float n = a0 * rr; p0[r] = a0 - n; a0 = n; }
        const auto s0 = __builtin_amdgcn_permlane32_swap(__float_as_uint(a0), __float_as_uint(a0), false, false);
        const float a0lo = __uint_as_float(s0[0]), a0hi = __uint_as_float(s0[1]);
        const float base0 = hi ? Cc : Cc * a0hi;
        Cc = Cc * a0hi * a0lo;
#pragma unroll
        for (int r = 0; r < 16; ++r) p0[r] *= base0;
        SBA_PV(p0, 0);
    }
#undef SBA_PV
}

#define SBA_WAITBAR(N) asm volatile("s_waitcnt vmcnt(" #N ") lgkmcnt(0)\n\ts_barrier" ::: "memory")
__device__ __forceinline__ void attn_unit(int b, int h, int qb, const bf16* Q, const bf16* K, const bf16* V, bf16* O, char* shm) {
    const int tid = threadIdx.x, lane = tid & 63, r32 = lane & 31, hi = lane >> 5; const int wid = __builtin_amdgcn_readfirstlane(tid >> 6);
    const long rowbase = (long)b * SEQ; const int q0 = qb * QB;
    const bf16* Qw = Q + (rowbase + q0 + wid * QBLK) * DM + h * HD;
    const bf16* Kh = K + rowbase * DM + h * HD; const bf16* Vh = V + rowbase * DM + h * HD;
    const unsigned lds0 = (unsigned)(uintptr_t)shm;
    const bf16* ksrc = Kh + (long)lane * DM + wid * 8;
    const bf16* vsrc = Vh + (long)(16 * (wid & 3) + (lane >> 2)) * DM + (wid >> 2) * 32 + (lane & 3) * 8;
    const unsigned kdst = lds0 + LDS_K + wid * 1024, vdst = lds0 + LDS_V + wid * 1024;
#define SBA_DMA_K(t, slot) glds16(ksrc + (long)(t) * KVBLK * DM, (unsigned)__builtin_amdgcn_readfirstlane(kdst + (slot)))
#define SBA_DMA_V(t, slot) glds16(vsrc + (long)(t) * KVBLK * DM, (unsigned)__builtin_amdgcn_readfirstlane(vdst + (slot)))
    const lds_cptr shm3 = (lds_cptr)shm;
    const int pir = 16 * ((r32 >> 2) & 1) + (r32 & 3) + 4 * (r32 >> 3);
    const lds_cptr kp0 = shm3 + LDS_K + hi * 1024 + pir * 16;
    const lds_cptr vp0 = shm3 + LDS_V + ((lane >> 4) & 1) * 32 + (lane & 3) * 8 + (16 * hi + ((lane & 15) >> 2)) * 64;
    const int NT = 4 * qb + 4, tstart = 4 * qb + (wid >> 1);
    volatile __attribute__((address_space(3))) unsigned* fin = (volatile __attribute__((address_space(3))) unsigned*)(shm3 + LDS_FIN);
    if (tid == 0) fin[0] = 0u;
    { const bf16* qsrc = Qw + (long)(lane >> 3) * DM + (lane & 7) * 8; const unsigned qdst = lds0 + LDS_OST + wid * 4096;
#pragma unroll
      for (int j = 0; j < 4; ++j) glds16(qsrc + (long)(8 * j) * DM, (unsigned)__builtin_amdgcn_readfirstlane(qdst + j * 1024)); }
    SBA_DMA_K(NT - 1, 0); SBA_DMA_V(NT - 1, 0); SBA_DMA_K(NT - 2, SLOTB); SBA_DMA_V(NT - 2, SLOTB);
    bf16x8 qr[4];
    f32x16 o[2]; o[0] = f32x16{}; o[1] = f32x16{};
    float Cc = 1.f;
    const int qpos = q0 + wid * QBLK + r32;
    bool done = false;
    for (int i = 0;; ++i) {
        const int t = NT - 1 - i, so = (i & 3) * SLOTB;
        if (t >= 2) { SBA_DMA_K(t - 2, ((i + 2) & 3) * SLOTB); SBA_DMA_V(t - 2, ((i + 2) & 3) * SLOTB); SBA_WAITBAR(4); }
        else if (t == 1) { SBA_WAITBAR(2); } else { SBA_WAITBAR(0); }
        if (fin[0] == NW) break;
        if (i == 0) {
#pragma unroll
            for (int d0 = 0; d0 < 4; ++d0) qr[d0] = *(const __attribute__((address_space(3))) bf16x8*)(shm3 + LDS_OST + wid * 4096 + r32 * 128 + d0 * 32 + hi * 16); }
        if (t <= tstart && !done) {
            const int kq = t * KVBLK - qpos + 16 * hi;
            if (t == tstart) tile<true>(o, Cc, qr, kp0 + so, vp0 + so, kq, hi, (wid & 1) == 0); else tile<false>(o, Cc, qr, kp0 + so, vp0 + so, kq, hi, false);
            if (__all(Cc < SBA_EXIT_MASS)) { done = true; if (lane == 0) __hip_atomic_fetch_add((__attribute__((address_space(3))) unsigned*)(shm3 + LDS_FIN), 1u, __ATOMIC_RELAXED, __HIP_MEMORY_SCOPE_WORKGROUP); }
        }
        if (t == 0) break;
    }
    bf16* Ow = O + (rowbase + q0 + wid * QBLK) * DM + h * HD;
    { bf16* stg = (bf16*)(shm + LDS_OST) + wid * 2048;
#pragma unroll
      for (int r = 0; r < 16; ++r) { const int orow = crow(r, hi);
#pragma unroll
        for (int d0 = 0; d0 < 2; ++d0) stg[orow * 64 + d0 * 32 + r32] = (bf16)f2bf(o[d0][r]); }
      asm volatile("s_waitcnt lgkmcnt(0)" ::: "memory");
#pragma unroll
      for (int i = 0; i < 4; ++i) { const int row = i * 8 + (lane >> 3), ch = lane & 7; const v4u v = *(const v4u*)(stg + row * 64 + ch * 8); *(v4u*)(Ow + (long)row * DM + ch * 8) = v; } }
    asm volatile("s_waitcnt vmcnt(0) lgkmcnt(0)\n\ts_barrier" ::: "memory");
#undef SBA_DMA_K
#undef SBA_DMA_V
}
}

struct Args { const float* in[23]; float* out; unsigned char* ws; int ph_lo, ph_hi, li, pad; };
struct Frame {
    LAS unsigned char* lds;
    volatile LAS unsigned* MISC;
    gu32* ctl;
    int tid, lane, wave;
    int vcu, G;
    float* out; unsigned char* ws;
};
__device__ __forceinline__ float wave_sum(float v) {
#pragma unroll
    for (int o = 1; o < 64; o <<= 1) v += __shfl_xor(v, o);
    return v;
}
__device__ __forceinline__ void ld_row_f32(const float* p, int lane, float (&v)[16]) {
#pragma unroll
    for (int j = 0; j < 4; ++j) { const f32x4 t = ((const GAS f32x4*)p)[64 * j + lane]; v[4 * j] = t.x; v[4 * j + 1] = t.y; v[4 * j + 2] = t.z; v[4 * j + 3] = t.w; } }
__device__ __forceinline__ void st_row_f32(float* p, int lane, const float (&v)[16]) {
#pragma unroll
    for (int j = 0; j < 4; ++j) ((GAS f32x4*)p)[64 * j + lane] = (f32x4){v[4 * j], v[4 * j + 1], v[4 * j + 2], v[4 * j + 3]}; }
__device__ __forceinline__ void ld_row_bf16(const bf16* p, int lane, float (&v)[16]) {
#pragma unroll
    for (int j = 0; j < 4; ++j) { const v2u t = ((const GAS v2u*)p)[64 * j + lane]; v[4 * j] = bf_lo(t.x); v[4 * j + 1] = bf_hi(t.x); v[4 * j + 2] = bf_lo(t.y); v[4 * j + 3] = bf_hi(t.y); } }
__device__ __forceinline__ void ldraw_f32(const float* p, int lane, f32x4 (&r)[4]) {
#pragma unroll
    for (int j = 0; j < 4; ++j) r[j] = ((const GAS f32x4*)p)[64 * j + lane]; }
__device__ __forceinline__ void ldraw_bf16(const bf16* p, int lane, v2u (&r)[4]) {
#pragma unroll
    for (int j = 0; j < 4; ++j) r[j] = ((const GAS v2u*)p)[64 * j + lane]; }
__device__ __forceinline__ void cvraw_f32(const f32x4 (&r)[4], float (&v)[16]) {
#pragma unroll
    for (int j = 0; j < 4; ++j) { v[4 * j] = r[j].x; v[4 * j + 1] = r[j].y; v[4 * j + 2] = r[j].z; v[4 * j + 3] = r[j].w; } }
__device__ __forceinline__ void cvraw_bf16(const v2u (&r)[4], float (&v)[16]) {
#pragma unroll
    for (int j = 0; j < 4; ++j) { v[4 * j] = bf_lo(r[j].x); v[4 * j + 1] = bf_hi(r[j].x); v[4 * j + 2] = bf_lo(r[j].y); v[4 * j + 3] = bf_hi(r[j].y); } }
__device__ __forceinline__ void st_row_bf16(bf16* p, int lane, const float (&v)[16]) {
#pragma unroll
    for (int j = 0; j < 4; ++j) { v2u t; t.x = pk2(v[4 * j], v[4 * j + 1]); t.y = pk2(v[4 * j + 2], v[4 * j + 3]); ((GAS v2u*)p)[64 * j + lane] = t; } }
__device__ __forceinline__ unsigned pack_i8(float a, float b, float c, float d) {
    const int ia = (int)__builtin_fminf(__builtin_fmaxf(__builtin_rintf(a), -127.f), 127.f), ib = (int)__builtin_fminf(__builtin_fmaxf(__builtin_rintf(b), -127.f), 127.f);
    const int ic = (int)__builtin_fminf(__builtin_fmaxf(__builtin_rintf(c), -127.f), 127.f), id = (int)__builtin_fminf(__builtin_fmaxf(__builtin_rintf(d), -127.f), 127.f);
    return (unsigned)(ia & 255) | ((unsigned)(ib & 255) << 8) | ((unsigned)(ic & 255) << 16) | ((unsigned)(id & 255) << 24); }
__device__ __forceinline__ float wave_max(float v) {
#pragma unroll
    for (int o = 1; o < 64; o <<= 1) v = __builtin_fmaxf(v, __shfl_xor(v, o));
    return v; }
__device__ __forceinline__ float st_row_i8(unsigned char* p, int lane, const float (&v)[16]) {
    float mx = 0.f;
#pragma unroll
    for (int i = 0; i < 16; ++i) mx = __builtin_fmaxf(mx, __builtin_fabsf(v[i]));
    mx = __builtin_fmaxf(wave_max(mx), 1e-20f); const float q = 127.0f / mx;
#pragma unroll
    for (int j = 0; j < 4; ++j) ((GAS unsigned*)p)[64 * j + lane] = pack_i8(q * v[4 * j], q * v[4 * j + 1], q * v[4 * j + 2], q * v[4 * j + 3]);
    return mx * (1.0f / 127.0f); }
__device__ __forceinline__ float sumsq16(const float (&v)[16]) { float s = 0.f;
#pragma unroll
    for (int i = 0; i < 16; ++i) s += v[i] * v[i];
    return s; }

__device__ __forceinline__ int row_of(int wg, int wave, int k) { return (wg * NWAVES + wave) * 16 + k; }
__device__ __forceinline__ void p0_transpose_item(const float* W, int K, int N, bf16* WT, int k0, int ns, int nd, LAS float* scr, int lane) {
    { f32x4 t_[8];
#pragma unroll
      for (int i = 0; i < 8; ++i) t_[i] = __builtin_nontemporal_load((const GAS f32x4*)(W + (size_t)(k0 + 8 * i + (lane >> 3)) * N + ns + 4 * (lane & 7)));
#pragma unroll
      for (int i = 0; i < 8; ++i) { LAS float* d_ = scr + (8 * i + (lane >> 3)) * 33 + 4 * (lane & 7); d_[0] = t_[i].x; d_[1] = t_[i].y; d_[2] = t_[i].z; d_[3] = t_[i].w; } }
    LDS_WAIT(); asm volatile("" ::: "memory");
    const int c = lane & 7;
#pragma unroll
    for (int j = 0; j < 4; ++j) { const int n = (lane >> 3) + 8 * j; const LAS float* s = scr + (8 * c) * 33 + n;
        v4u o; o.x = pk2(s[0 * 33], s[1 * 33]); o.y = pk2(s[2 * 33], s[3 * 33]); o.z = pk2(s[4 * 33], s[5 * 33]); o.w = pk2(s[6 * 33], s[7 * 33]);
        __builtin_nontemporal_store(o, (GAS v4u*)(WT + (size_t)(nd + n) * K + k0 + 8 * c)); }
    LDS_WAIT(); asm volatile("" ::: "memory");
}
__device__ __forceinline__ void p0_transpose_item8(const float* W, int K, int N, unsigned char* WT, int k0, int ns, int nd, float scl, LAS float* scr, int lane) {
    { f32x4 t_[8];
#pragma unroll
      for (int i = 0; i < 8; ++i) t_[i] = __builtin_nontemporal_load((const GAS f32x4*)(W + (size_t)(k0 + 8 * i + (lane >> 3)) * N + ns + 4 * (lane & 7)));
#pragma unroll
      for (int i = 0; i < 8; ++i) { LAS float* d_ = scr + (8 * i + (lane >> 3)) * 33 + 4 * (lane & 7); d_[0] = t_[i].x; d_[1] = t_[i].y; d_[2] = t_[i].z; d_[3] = t_[i].w; } }
    LDS_WAIT(); asm volatile("" ::: "memory");
    const int c = lane & 3;
#pragma unroll
    for (int j = 0; j < 2; ++j) { const int n = (lane >> 2) + 16 * j; const LAS float* s = scr + (16 * c) * 33 + n;
        v4u o; o.x = pg8::cvt4_fp8(scl * s[0 * 33], scl * s[1 * 33], scl * s[2 * 33], scl * s[3 * 33]); o.y = pg8::cvt4_fp8(scl * s[4 * 33], scl * s[5 * 33], scl * s[6 * 33], scl * s[7 * 33]);
        o.z = pg8::cvt4_fp8(scl * s[8 * 33], scl * s[9 * 33], scl * s[10 * 33], scl * s[11 * 33]); o.w = pg8::cvt4_fp8(scl * s[12 * 33], scl * s[13 * 33], scl * s[14 * 33], scl * s[15 * 33]);
        __builtin_nontemporal_store(o, (GAS v4u*)(WT + (size_t)(nd + n) * K + k0 + 16 * c)); }
    LDS_WAIT(); asm volatile("" ::: "memory");
}
__device__ __forceinline__ void p0_transpose_item_i8(const float* W, int K, int N, unsigned char* WT, int k0, int ns, int nd, float scl, LAS float* scr, int lane) {
    { f32x4 t_[8];
#pragma unroll
      for (int i = 0; i < 8; ++i) t_[i] = __builtin_nontemporal_load((const GAS f32x4*)(W + (size_t)(k0 + 8 * i + (lane >> 3)) * N + ns + 4 * (lane & 7)));
#pragma unroll
      for (int i = 0; i < 8; ++i) { LAS float* d_ = scr + (8 * i + (lane >> 3)) * 33 + 4 * (lane & 7); d_[0] = t_[i].x; d_[1] = t_[i].y; d_[2] = t_[i].z; d_[3] = t_[i].w; } }
    LDS_WAIT(); asm volatile("" ::: "memory");
    const int c = lane & 3;
#pragma unroll
    for (int j = 0; j < 2; ++j) { const int n = (lane >> 2) + 16 * j; const LAS float* s = scr + (16 * c) * 33 + n;
        v4u o; o.x = pack_i8(scl * s[0 * 33], scl * s[1 * 33], scl * s[2 * 33], scl * s[3 * 33]); o.y = pack_i8(scl * s[4 * 33], scl * s[5 * 33], scl * s[6 * 33], scl * s[7 * 33]);
        o.z = pack_i8(scl * s[8 * 33], scl * s[9 * 33], scl * s[10 * 33], scl * s[11 * 33]); o.w = pack_i8(scl * s[12 * 33], scl * s[13 * 33], scl * s[14 * 33], scl * s[15 * 33]);
        __builtin_nontemporal_store(o, (GAS v4u*)(WT + (size_t)(nd + n) * K + k0 + 16 * c)); }
    LDS_WAIT(); asm volatile("" ::: "memory");
}
__device__ __forceinline__ void p0_tri8(const float* W, int K, int N, unsigned char* WT, bool glu, float scl, int r, LAS float* scr, int lane) {
    const int nblk = N / 32, kb = r / nblk, nb = r % nblk, nd = 32 * nb; int ns = nd;
    if (glu) { const int tile = nd >> 8, w = nd & 255; ns = (w < 128) ? tile * 128 + w : (N >> 1) + tile * 128 + (w - 128); }
    p0_transpose_item_i8(W, K, N, WT, 64 * kb, ns, nd, scl, scr, lane);
}
__device__ __forceinline__ void p0_tr8(const float* W, int K, int N, unsigned char* WT, bool glu, float scl, int r, LAS float* scr, int lane) {
    const int nblk = N / 32, kb = r / nblk, nb = r % nblk, nd = 32 * nb; int ns = nd;
    if (glu) { const int tile = nd >> 8, w = nd & 255; ns = (w < 128) ? tile * 128 + w : (N >> 1) + tile * 128 + (w - 128); }
    p0_transpose_item8(W, K, N, WT, 64 * kb, ns, nd, scl, scr, lane);
}
__device__ __forceinline__ void p0_tr(const float* W, int K, int N, bf16* WT, bool glu, int r, LAS float* scr, int lane) {
    const int nblk = N / 32, kb = r / nblk, nb = r % nblk, nd = 32 * nb; int ns = nd;
    if (glu) { const int tile = nd >> 8, w = nd & 255; ns = (w < 128) ? tile * 128 + w : (N >> 1) + tile * 128 + (w - 128); }
    p0_transpose_item(W, K, N, WT, 64 * kb, ns, nd, scr, lane);
}
__device__ __forceinline__ void p0_s5_tables(Frame& F, const Args& AR, int g) {
    const float* lam_re = AR.in[6] + g * 64; const float* lam_im = AR.in[7] + g * 64;
    const float* b_re = AR.in[8] + g * 1024; const float* b_im = AR.in[9] + g * 1024;
    const float* c_re = AR.in[10] + g * 1024; const float* c_im = AR.in[11] + g * 1024;
    const float* dsk = AR.in[12] + g * 16; const float step = expf(AR.in[13][g]);
    LAS float* PW = (LAS float*)(F.lds + RING_OFF);
    LAS float* BB = PW + 64 * 65 * 2;
    LAS float* CC = BB + 64 * 16 * 2;
    const int t = F.tid, p = t & 63, dq = t >> 6;
    { const float lr = lam_re[p] * step, li = lam_im[p] * step;
      for (int i = 0; i < 9; ++i) { const int d = dq * 8 + i; if (i == 8 && dq != 7) break;
          const float mg = expf(lr * (float)d); float sn, cs; sincosf(li * (float)d, &sn, &cs); PW[(p * 65 + d) * 2] = mg * cs; PW[(p * 65 + d) * 2 + 1] = mg * sn; }
      if (dq == 0) { const float mg = expf(lr); float sn, cs; sincosf(li, &sn, &cs); const float lbr = mg * cs, lbi = mg * sn, a = lam_re[p], bq = lam_im[p], den = a * a + bq * bq;
          const float cr = ((lbr - 1.0f) * a + lbi * bq) / den, ci = (lbi * a - (lbr - 1.0f) * bq) / den;
          for (int h = 0; h < 16; ++h) { const float br = b_re[p * 16 + h], bi = b_im[p * 16 + h]; BB[(p * 16 + h) * 2] = cr * br - ci * bi; BB[(p * 16 + h) * 2 + 1] = cr * bi + ci * br; } }
      for (int idx = t; idx < 1024; idx += 512) { CC[idx * 2] = c_re[idx]; CC[idx * 2 + 1] = c_im[idx]; }
    }
    __syncthreads();
    bf16* W1 = (bf16*)(F.ws + WS_W1) + (size_t)g * 128 * 512;
    for (int pi = t; pi < 128 * 64; pi += 512) { const int q = pi >> 6, rem = pi & 63, k = rem >> 1, h0 = (rem & 1) * 8, pp = q & 63; float v[8];
        const float pr = PW[(pp * 65 + 31 - k) * 2], pim = PW[(pp * 65 + 31 - k) * 2 + 1];
#pragma unroll
        for (int j = 0; j < 8; ++j) { const float br = BB[(pp * 16 + h0 + j) * 2], bi = BB[(pp * 16 + h0 + j) * 2 + 1]; v[j] = (q < 64) ? pr * br - pim * bi : pr * bi + pim * br; }
        v4u o; o.x = pk2(v[0], v[1]); o.y = pk2(v[2], v[3]); o.z = pk2(v[4], v[5]); o.w = pk2(v[6], v[7]);
        *(GAS v4u*)(W1 + (size_t)q * 512 + k * 16 + h0) = o; }
    bf16* TW = (bf16*)(F.ws + WS_TW) + (size_t)g * 512 * 640;
    for (int pi = t; pi < 512 * 16; pi += 512) { const int row = pi >> 4, q0 = (pi & 15) * 8, tau = row >> 4, hp = row & 15; float v[8];
#pragma unroll
        for (int j = 0; j < 8; ++j) { const int q = q0 + j, pp = q & 63; const float cr = CC[(hp * 64 + pp) * 2], ci = CC[(hp * 64 + pp) * 2 + 1], pr = PW[(pp * 65 + tau + 1) * 2], pim = PW[(pp * 65 + tau + 1) * 2 + 1];
            v[j] = (q < 64) ? cr * pr - ci * pim : -(cr * pim + ci * pr); }
        v4u o; o.x = pk2(v[0], v[1]); o.y = pk2(v[2], v[3]); o.z = pk2(v[4], v[5]); o.w = pk2(v[6], v[7]);
        *(GAS v4u*)(TW + (size_t)row * 640 + 512 + q0) = o; }
    if (t < 64) { float* lamT = (float*)(F.ws + WS_RT + RT_LAMT) + (g * 64 + t) * 2; lamT[0] = PW[(t * 65 + 32) * 2]; lamT[1] = PW[(t * 65 + 32) * 2 + 1]; }
    { const int hh = t & 255, hp = hh >> 4, h = hh & 15, dh = t >> 8; float acc[16];
#pragma unroll
      for (int i = 0; i < 16; ++i) acc[i] = 0.f;
      for (int pp = 0; pp < 64; ++pp) { const float cr = CC[(hp * 64 + pp) * 2], ci = CC[(hp * 64 + pp) * 2 + 1], br = BB[(pp * 16 + h) * 2], bi = BB[(pp * 16 + h) * 2 + 1];
          const float xr = cr * br - ci * bi, xi = cr * bi + ci * br; const LAS float* pw = PW + (pp * 65 + dh * 16) * 2;
#pragma unroll
          for (int i = 0; i < 16; ++i) acc[i] += pw[2 * i] * xr - pw[2 * i + 1] * xi; }
      if (dh == 0 && hp == h) acc[0] += dsk[h];
      float* Kt = (float*)(F.ws + WS_KTAB) + (size_t)g * 32 * 256;
#pragma unroll
      for (int i = 0; i < 16; ++i) Kt[(dh * 16 + i) * 256 + hh] = acc[i]; }
    __syncthreads();
}
__device__ __forceinline__ void p0_mod_item(Frame& F, const Args& AR, int mi) {
    const int layer = mi / 96, n0 = (mi % 96) * 64;
    LAS float* cT = (LAS float*)(F.lds + RING_OFF);
    LAS float* part = cT + 16384;
    for (int idx = F.tid; idx < 16384; idx += 512) { const int b = idx >> 10, k = idx & 1023; const float v = AR.in[1][idx]; cT[k * 16 + b] = v / (1.0f + expf(-v)); }
    __syncthreads();
    float acc[16];
#pragma unroll
    for (int b = 0; b < 16; ++b) acc[b] = 0.f;
    const float* W = AR.in[2] + (size_t)layer * 1024 * 6144 + n0 + F.lane;
    for (int kb = 0; kb < 128; kb += 8) { float wv[8];
#pragma unroll
        for (int u = 0; u < 8; ++u) wv[u] = __builtin_nontemporal_load(W + (size_t)(F.wave * 128 + kb + u) * 6144);
#pragma unroll
        for (int u = 0; u < 8; ++u) { const LAS f32x4* c4 = (const LAS f32x4*)(cT + (F.wave * 128 + kb + u) * 16);
#pragma unroll
            for (int q = 0; q < 4; ++q) { const f32x4 c = c4[q]; acc[4 * q] += wv[u] * c.x; acc[4 * q + 1] += wv[u] * c.y; acc[4 * q + 2] += wv[u] * c.z; acc[4 * q + 3] += wv[u] * c.w; } } }
#pragma unroll
    for (int b = 0; b < 16; ++b) part[(F.wave * 16 + b) * 64 + F.lane] = acc[b];
    __syncthreads();
    float* mod = (float*)(F.ws + WS_MOD);
    for (int idx = F.tid; idx < 1024; idx += 512) { const int b = idx >> 6, col = idx & 63; float s = AR.in[3][layer * 6144 + n0 + col];
#pragma unroll
        for (int w = 0; w < 8; ++w) s += part[(w * 16 + b) * 64 + col];
        mod[(size_t)(layer * 16 + b) * 6144 + n0 + col] = s; }
    __syncthreads();
}
__device__ __forceinline__ void p0_prologue(Frame& F, const Args& AR) {
    const int bx = blockIdx.x;
    {
    if (bx < 32) p0_s5_tables(F, AR, bx);
    else if (bx < 32 + 192) p0_mod_item(F, AR, bx - 32);
    }
    LAS float* scr = (LAS float*)(F.lds + RING_OFF + F.wave * 16384);
    constexpr int I_IN = 16 * 16, I_OUT = 8 * 64, I_GU = 16 * 224, I_D = 56 * 32, I_QKV = 16 * 96, I_O = 16 * 32;
    constexpr int NITEMS = I_IN + I_OUT + I_GU + I_D + I_QKV + I_O + 8 * I_GU + 8 * I_D;
    {
    gu32* ctr = F.ctl + CW_P0CTR + 64 * (bx & 7);
    for (;;) {
      int it0 = 0; if (F.lane == 0) it0 = (int)__hip_atomic_fetch_add(ctr, 1u, RLX_AGENT);
      it0 = (__builtin_amdgcn_readfirstlane(it0) * 8 + (bx & 7)) * 4; if (it0 >= NITEMS) break;
      for (int it = it0; it < it0 + 4 && it < NITEMS; ++it) {
        int r = it;
        if (r < I_IN) { p0_tr(AR.in[5], 1024, 512, (bf16*)(F.ws + WS_WIN), false, r, scr, F.lane); continue; } r -= I_IN;
        if (r < I_OUT) { p0_tr(AR.in[14], 512, 2048, (bf16*)(F.ws + WS_WOUT), true, r, scr, F.lane); continue; } r -= I_OUT;
        if (r < I_GU) { p0_tri8(AR.in[17], 1024, 7168, (unsigned char*)(F.ws + WS_WGU), true, W8_Q, r, scr, F.lane); continue; } r -= I_GU;
        if (r < I_D) { p0_tr8(AR.in[18], 3584, 1024, (unsigned char*)(F.ws + WS_WD), false, 64.f, r, scr, F.lane); continue; } r -= I_D;
        if (r < I_QKV) { p0_tri8(AR.in[15], 1024, 3072, (unsigned char*)(F.ws + WS_WQKV), false, W8_Q, r, scr, F.lane); continue; } r -= I_QKV;
        if (r < I_O) { p0_tr(AR.in[16], 1024, 1024, (bf16*)(F.ws + WS_WO), false, r, scr, F.lane); continue; } r -= I_O;
        if (r < 8 * I_GU) { const int e = r / I_GU; p0_tri8(AR.in[21] + (size_t)e * 1024 * 7168, 1024, 7168, (unsigned char*)(F.ws + WS_MWGU) + (size_t)e * 7168 * 1024, true, W8_Q, r % I_GU, scr, F.lane); continue; } r -= 8 * I_GU;
        { const int e = r / I_D; p0_tr8(AR.in[22] + (size_t)e * 3584 * 1024, 3584, 1024, (unsigned char*)(F.ws + WS_MWD) + (size_t)e * 1024 * 3584, false, 64.f, r % I_D, scr, F.lane); }
      }
    }
    }
}

__device__ __forceinline__ void p1_norm_expand(Frame& F, const Args& AR) {
    const int row0 = row_of(blockIdx.x, F.wave, 0), b = row0 >> 11;
    const float* mod = (const float*)(F.ws + WS_MOD) + (size_t)(0 * 16 + b) * 6144;
    float gs[16], sh[16];
    { float g0[16], sc[16]; ld_row_f32(AR.in[4] + 0 * 1024, F.lane, g0); ld_row_f32(mod + 1024, F.lane, sc); ld_row_f32(mod, F.lane, sh);
#pragma unroll
      for (int i = 0; i < 16; ++i) gs[i] = g0[i] * (1.0f + sc[i]); }
    bf16* H = (bf16*)(F.ws + WS_H);
    f32x4 xn_[4]; ldraw_f32(AR.in[0] + (size_t)row0 * DM, F.lane, xn_);
    for (int rr = 0; rr < 16; ++rr) { const int row = row0 + rr; float v[16]; cvraw_f32(xn_, v);
        if (rr + 1 < 16) ldraw_f32(AR.in[0] + (size_t)(row + 1) * DM, F.lane, xn_);
        const float rstd = rsqrtf(wave_sum(sumsq16(v)) * (1.0f / DM) + NORM_EPS);
#pragma unroll
        for (int i = 0; i < 16; ++i) v[i] = v[i] * rstd * gs[i] + sh[i];
        st_row_bf16(H + (size_t)row * DM, F.lane, v); }
}
__device__ __forceinline__ void s5_expand_tw(Frame& F, int first_wg) {
    const int nw = (F.G - first_wg) * NWAVES;
    for (int item = ((int)blockIdx.x - first_wg) * NWAVES + F.wave; item < 1024; item += nw) {
      const int g = item >> 5, tau = item & 31; const float* Kt = (const float*)(F.ws + WS_KTAB) + (size_t)g * 32 * 256; bf16* TW = (bf16*)(F.ws + WS_TW) + ((size_t)g * 512 + tau * 16) * 640;
#pragma unroll 8
      for (int it = 0; it < 16; ++it) { const int pi = it * 64 + F.lane, hp = pi >> 6, rem = pi & 63, k = rem >> 1, h0 = (rem & 1) * 8; v4u o = (v4u){0u, 0u, 0u, 0u};
          { const int dd = tau - k; const GAS f32x4* s = (const GAS f32x4*)(Kt + (dd < 0 ? 0 : dd) * 256 + hp * 16 + h0); const f32x4 a = s[0], c = s[1];
            o.x = pk2(a.x, a.y); o.y = pk2(a.z, a.w); o.z = pk2(c.x, c.y); o.w = pk2(c.z, c.w); if (dd < 0) o = (v4u){0u, 0u, 0u, 0u}; }
          *(GAS v4u*)(TW + (size_t)hp * 640 + k * 16 + h0) = o; } }
}
template <bool ROUTE, bool XF32> __device__ __forceinline__ void normres_phase(
    Frame& F, const Args& AR, const float* xold, const float* gA, const float* gate_off, const float* gB, const float* scaleN_off, const float* shiftN_off) {
    const int row0 = row_of(blockIdx.x, F.wave, 0), b = row0 >> 11;
    float cg[16], gbs[16], sh[16];
    { float a[16], c[16]; ld_row_f32(gA, F.lane, a); ld_row_f32(gate_off + (size_t)b * 6144, F.lane, c);
#pragma unroll
      for (int i = 0; i < 16; ++i) cg[i] = a[i] * c[i];
      ld_row_f32(gB, F.lane, a); ld_row_f32(scaleN_off + (size_t)b * 6144, F.lane, c);
#pragma unroll
      for (int i = 0; i < 16; ++i) gbs[i] = a[i] * (1.0f + c[i]);
      ld_row_f32(shiftN_off + (size_t)b * 6144, F.lane, sh); }
    const bf16* YB = (const bf16*)(F.ws + WS_YB); bf16* H = (bf16*)(F.ws + WS_H);
    LAS float* WR = (LAS float*)(F.lds + RING_OFF);
    LAS int* cntl = (LAS int*)(F.lds + RING_OFF + 32768);
    int mycnt[8];
    if (ROUTE) { for (int idx = F.tid; idx < 8192; idx += 512) { const int el = idx >> 3, ee = idx & 7, jj = el >> 8, ll = (el >> 2) & 63, ii = el & 3; WR[(((4 * jj + ii) * 64 + ll) << 3) + ee] = AR.in[19][idx]; } __syncthreads();
#pragma unroll
        for (int e = 0; e < 8; ++e) mycnt[e] = 0; }
    v2u yn_[4], xbn_[4]; f32x4 xfn_[4];
    ldraw_bf16(YB + (size_t)row0 * DM, F.lane, yn_); if (XF32) ldraw_f32(xold + (size_t)row0 * DM, F.lane, xfn_); else ldraw_bf16((const bf16*)(F.ws + WS_XR) + (size_t)row0 * DM, F.lane, xbn_);
    for (int rr = 0; rr < 16; ++rr) { const int row = row0 + rr; float y[16], x[16];
        cvraw_bf16(yn_, y); if (XF32) cvraw_f32(xfn_, x); else cvraw_bf16(xbn_, x);
        if (rr + 1 < 16) { ldraw_bf16(YB + (size_t)(row + 1) * DM, F.lane, yn_); if (XF32) ldraw_f32(xold + (size_t)(row + 1) * DM, F.lane, xfn_); else ldraw_bf16((const bf16*)(F.ws + WS_XR) + (size_t)(row + 1) * DM, F.lane, xbn_); }
        const float rstd = rsqrtf(wave_sum(sumsq16(y)) * (1.0f / DM) + NORM_EPS);
#pragma unroll
        for (int i = 0; i < 16; ++i) x[i] = x[i] + y[i] * rstd * cg[i];
        st_row_bf16((bf16*)(F.ws + WS_XR) + (size_t)row * DM, F.lane, x);
        const float rstd2 = rsqrtf(wave_sum(sumsq16(x)) * (1.0f / DM) + NORM_EPS);
#pragma unroll
        for (int i = 0; i < 16; ++i) y[i] = x[i] * rstd2 * gbs[i] + sh[i];
        { const float rsc = st_row_i8((unsigned char*)H + (size_t)row * DM, F.lane, y); if (F.lane == 0) ((float*)(F.ws + WS_SH))[row] = rsc; }
        if (ROUTE) { float lg[8];
#pragma unroll
            for (int e = 0; e < 8; ++e) lg[e] = 0.f;
#pragma unroll
            for (int j = 0; j < 4; ++j) { asm volatile("" ::: "memory");
#pragma unroll
                for (int i = 0; i < 4; ++i) { const LAS f32x4* w = (const LAS f32x4*)(WR + ((4 * j + i) * 64 + F.lane) * 8); const f32x4 w0 = w[0], w1 = w[1]; const float hv = y[4 * j + i];
                    lg[0] += hv * w0.x; lg[1] += hv * w0.y; lg[2] += hv * w0.z; lg[3] += hv * w0.w; lg[4] += hv * w1.x; lg[5] += hv * w1.y; lg[6] += hv * w1.z; lg[7] += hv * w1.w; } }
            {
              const bool b5 = (F.lane & 32) != 0, b4 = (F.lane & 16) != 0, b3 = (F.lane & 8) != 0; float q4[4], q2[2], q1;
#pragma unroll
              for (int e = 0; e < 4; ++e) { const float keep = b5 ? lg[e + 4] : lg[e], send = b5 ? lg[e] : lg[e + 4]; q4[e] = keep + __shfl_xor(send, 32); }
#pragma unroll
              for (int e = 0; e < 2; ++e) { const float keep = b4 ? q4[e + 2] : q4[e], send = b4 ? q4[e] : q4[e + 2]; q2[e] = keep + __shfl_xor(send, 16); }
              { const float keep = b3 ? q2[1] : q2[0], send = b3 ? q2[0] : q2[1]; q1 = keep + __shfl_xor(send, 8); }
              q1 += __shfl_xor(q1, 4); q1 += __shfl_xor(q1, 2); q1 += __shfl_xor(q1, 1);
#pragma unroll
              for (int e = 0; e < 8; ++e) lg[e] = __builtin_bit_cast(float, __builtin_amdgcn_readlane(__builtin_bit_cast(int, q1), 8 * e)) + AR.in[20][e]; }
            int e1 = 0; float l1 = lg[0];
#pragma unroll
            for (int e = 1; e < 8; ++e) if (lg[e] > l1) { l1 = lg[e]; e1 = e; }
            int e2 = -1; float l2 = -3.0e38f;
#pragma unroll
            for (int e = 0; e < 8; ++e) if (e != e1 && lg[e] > l2) { l2 = lg[e]; e2 = e; }
            const float g1 = 1.0f / (1.0f + expf(l2 - l1));
#pragma unroll
            for (int e = 0; e < 8; ++e) mycnt[e] += (e == e1 || e == e2) ? 1 : 0;
            if (F.lane == 0) { ((int*)(F.ws + WS_RT + RT_E))[row] = e1 | (e2 << 8); ((float*)(F.ws + WS_RT + RT_G))[row] = g1; } }
    }
    if (ROUTE) {
        if (F.lane < 8) { int c = 0;
#pragma unroll
            for (int e = 0; e < 8; ++e) c = (F.lane == e) ? mycnt[e] : c;
            cntl[F.wave * 8 + F.lane] = c; }
        __syncthreads();
        if (F.tid < 8) { int s = 0;
#pragma unroll
            for (int w = 0; w < 8; ++w) s += cntl[w * 8 + F.tid];
            ((int*)(F.ws + WS_RT + RT_CNT))[blockIdx.x * 8 + F.tid] = s; }
        __syncthreads();
    }
}
__device__ __forceinline__ void p14_slots(Frame& F, const Args& AR) {
    LAS int* L = (LAS int*)(F.lds + RING_OFF);
    const int* cnt = (const int*)(F.ws + WS_RT + RT_CNT);
    for (int idx = F.tid; idx < 2048; idx += 512) L[idx] = (int)__hip_atomic_load((unsigned*)cnt + idx, RLX_AGENT);
    __syncthreads();
    if (F.tid < 8) { int tot = 0, pre = 0; for (int w = 0; w < 256; ++w) { const int c = L[w * 8 + F.tid]; if (w < (int)blockIdx.x) pre += c; tot += c; } L[2048 + F.tid] = tot; L[2056 + F.tid] = pre; }
    __syncthreads();
    if (F.tid == 0) { int ts = 0; int* TS = (int*)(F.ws + WS_RT + RT_TS); const bool wr = (blockIdx.x == 0); for (int e = 0; e < 8; ++e) { L[2064 + e] = ts * 256; if (wr) TS[e] = ts; ts += (L[2048 + e] + 255) >> 8; } if (wr) TS[8] = ts; }
    __syncthreads();
    const int myrow = row_of(blockIdx.x, (F.tid >> 4) & 7, F.tid & 15);
    const int* RE = (const int*)(F.ws + WS_RT + RT_E);
    int e1 = 0, e2 = 0;
    if (F.tid < 128) { const int ee = RE[myrow]; e1 = ee & 255; e2 = ee >> 8; }
    if (F.wave < 2) {
#pragma unroll
        for (int e = 0; e < 8; ++e) { const unsigned long long m = __ballot(e1 == e || e2 == e); if (F.lane == 0) { L[2080 + (e * 2 + F.wave) * 2] = (int)(unsigned)m; L[2080 + (e * 2 + F.wave) * 2 + 1] = (int)(unsigned)(m >> 32); } } }
    __syncthreads();
    if (F.tid < 128) {
        int sl[2];
#pragma unroll
        for (int j = 0; j < 2; ++j) { const int e = j ? e2 : e1;
            const unsigned long long m0 = (unsigned long long)(unsigned)L[2080 + (e * 2 + 0) * 2] | ((unsigned long long)(unsigned)L[2080 + (e * 2 + 0) * 2 + 1] << 32);
            const unsigned long long m1 = (unsigned long long)(unsigned)L[2080 + (e * 2 + 1) * 2] | ((unsigned long long)(unsigned)L[2080 + (e * 2 + 1) * 2 + 1] << 32);
            const unsigned long long below = (1ull << F.lane) - 1ull;
            const int rank = (F.wave == 0) ? __popcll(m0 & below) : __popcll(m0) + __popcll(m1 & below);
            sl[j] = L[2064 + e] + L[2056 + e] + rank; }
        L[2112 + F.tid * 2] = sl[0]; L[2112 + F.tid * 2 + 1] = sl[1];
        int* RS = (int*)(F.ws + WS_RT + RT_SLOT); RS[myrow * 2] = sl[0]; RS[myrow * 2 + 1] = sl[1];
    }
    __syncthreads();
    const unsigned char* H = (const unsigned char*)(F.ws + WS_H); unsigned char* XP = (unsigned char*)(F.ws + WS_XP);
    const float* SH = (const float*)(F.ws + WS_SH); float* SX = (float*)(F.ws + WS_SX);
    for (int rr = 0; rr < 16; ++rr) { const int lr = F.wave * 16 + rr; const int s0 = L[2112 + lr * 2], s1 = L[2112 + lr * 2 + 1];
        const int grow = row_of(blockIdx.x, F.wave, rr); const v4u a = ((const GAS v4u*)(H + (size_t)grow * DM))[F.lane]; const float sc = SH[grow];
        ((GAS v4u*)(XP + (size_t)s0 * DM))[F.lane] = a; ((GAS v4u*)(XP + (size_t)s1 * DM))[F.lane] = a;
        if (F.lane == 0) { SX[s0] = sc; SX[s1] = sc; } }
    if (blockIdx.x < 8) { const int e = blockIdx.x, lo = L[2064 + e] + L[2048 + e], hiend = L[2064 + e] + (((L[2048 + e] + 255) >> 8) << 8);
        for (int r = lo + F.wave; r < hiend; r += NWAVES) { ((GAS v4u*)(XP + (size_t)r * DM))[F.lane] = (v4u){0u, 0u, 0u, 0u}; if (F.lane == 0) ((float*)(F.ws + WS_SX))[r] = 0.f; } }
    __syncthreads();
}
__device__ __forceinline__ void p17_final(Frame& F, const Args& AR) {
    const int row0 = row_of(blockIdx.x, F.wave, 0), b = row0 >> 11;
    float cg[16];
    { float a[16], c[16]; ld_row_f32(AR.in[4] + (1 * 4 + 3) * 1024, F.lane, a); ld_row_f32((const float*)(F.ws + WS_MOD) + (size_t)(16 + b) * 6144 + 5 * 1024, F.lane, c);
#pragma unroll
      for (int i = 0; i < 16; ++i) cg[i] = a[i] * c[i]; }
    const bf16* YS = (const bf16*)(F.ws + WS_YS); const int* RS = (const int*)(F.ws + WS_RT + RT_SLOT); const float* RG = (const float*)(F.ws + WS_RT + RT_G);
    int sl0 = 0, sl1 = 0; float gg = 0.f;
    if (F.lane < 16) { sl0 = RS[(row0 + F.lane) * 2]; sl1 = RS[(row0 + F.lane) * 2 + 1]; gg = RG[row0 + F.lane]; }
    const float* SLAB = (const float*)(F.ws + WS_SLAB);
    v2u an_[4], bn_[4], xn_[4];
    int c0 = __builtin_amdgcn_readlane(sl0, 0), c1 = __builtin_amdgcn_readlane(sl1, 0);
    if (c0 < 65536) ldraw_bf16(YS + (size_t)c0 * DM, F.lane, an_); if (c1 < 65536) ldraw_bf16(YS + (size_t)c1 * DM, F.lane, bn_); ldraw_bf16((const bf16*)(F.ws + WS_XR) + (size_t)row0 * DM, F.lane, xn_);
    for (int rr = 0; rr < 16; ++rr) { const int row = row0 + rr; const float g1 = __builtin_bit_cast(float, __builtin_amdgcn_readlane(__builtin_bit_cast(int, gg), rr)), g2 = 1.0f - g1;
        float ya[16], yb[16], x[16]; cvraw_bf16(xn_, x);
        if (c0 < 65536) cvraw_bf16(an_, ya); else {
#pragma unroll
            for (int i = 0; i < 16; ++i) ya[i] = 0.f;
            for (int ks = 0; ks < 7; ++ks) { float t_[16]; ld_row_f32(SLAB + ((size_t)ks * 2048 + (c0 - 65536)) * 1024, F.lane, t_);
#pragma unroll
                for (int i = 0; i < 16; ++i) ya[i] += t_[i]; } }
        if (c1 < 65536) cvraw_bf16(bn_, yb); else {
#pragma unroll
            for (int i = 0; i < 16; ++i) yb[i] = 0.f;
            for (int ks = 0; ks < 7; ++ks) { float t_[16]; ld_row_f32(SLAB + ((size_t)ks * 2048 + (c1 - 65536)) * 1024, F.lane, t_);
#pragma unroll
                for (int i = 0; i < 16; ++i) yb[i] += t_[i]; } }
        if (rr + 1 < 16) { c0 = __builtin_amdgcn_readlane(sl0, rr + 1); c1 = __builtin_amdgcn_readlane(sl1, rr + 1);
            if (c0 < 65536) ldraw_bf16(YS + (size_t)c0 * DM, F.lane, an_); if (c1 < 65536) ldraw_bf16(YS + (size_t)c1 * DM, F.lane, bn_); ldraw_bf16((const bf16*)(F.ws + WS_XR) + (size_t)(row + 1) * DM, F.lane, xn_); }
#pragma unroll
        for (int i = 0; i < 16; ++i) ya[i] = g1 * ya[i] + g2 * yb[i];
        const float rstd = rsqrtf(wave_sum(sumsq16(ya)) * (1.0f / DM) + NORM_EPS);
#pragma unroll
        for (int i = 0; i < 16; ++i) x[i] = x[i] + ya[i] * rstd * cg[i];
        st_row_f32(F.out + (size_t)row * DM, F.lane, x); }
}

struct OrderMN {
    int nM, nN, G, c; const char* A; const char* B; long ta, tb;
    __device__ __forceinline__ bool next(int i, pg8::Unit& u) const { if (!pg8::order_next(nM, nN, G, c, i, u.pm, u.pn)) return false; u.a = A + (long)u.pm * ta; u.b = B + (long)u.pn * tb; u.x = 0; return true; }
};
struct OrderS5A {
    int G, c; const char* UA; const char* W1;
    __device__ __forceinline__ bool next(int i, pg8::Unit& u) const { const int L = i * G + c; if (L >= 128) return false; const int g = L >> 2; u.pm = L & 3; u.pn = 0; u.x = g;
        u.a = UA + ((long)(g * 1024 + u.pm * 256) * 640) * 2; u.b = W1 + (long)g * 128 * 512 * 2; return true; }
};
struct OrderS5B {
    int G, c; const char* UA; const char* TW;
    __device__ __forceinline__ bool next(int i, pg8::Unit& u) const { const int L = i * G + c; if (L >= 256) return false; const int g = L >> 3; u.pm = (L >> 1) & 3; u.pn = L & 1; u.x = g;
        u.a = UA + ((long)(g * 1024 + u.pm * 256) * 640) * 2; u.b = TW + ((long)(g * 512 + u.pn * 256) * 640) * 2; return true; }
};
struct OrderTail {
    int nT, G, c; int ts[9]; const char* A; const char* B; long ta, tb, te;
    __device__ __forceinline__ bool next(int i, pg8::Unit& u) const { const int L = i * G + c; if (L >= nT * 28) return false;
        const int ks = L % 7, t2 = L / 7; u.pn = __builtin_amdgcn_readfirstlane(t2 & 3); u.pm = __builtin_amdgcn_readfirstlane(256 + (t2 >> 2)); u.x = __builtin_amdgcn_readfirstlane(ks); int e = 0;
#pragma unroll
        for (int j = 1; j < 8; ++j) e += (u.pm >= ts[j]) ? 1 : 0;
        u.a = A + (long)u.pm * ta + (long)u.x * 512; u.b = B + (long)e * te + (long)u.pn * tb + (long)u.x * 512; return true; }
};
struct OrderMoE {
    int nN, G, c; int ts[9]; const char* A; const char* B; long ta, tb, te;
    __device__ __forceinline__ bool next(int i, pg8::Unit& u) const { if (!pg8::order_next(ts[8], nN, G, c, i, u.pm, u.pn)) return false; int e = 0;
#pragma unroll
        for (int j = 1; j < 8; ++j) e += (u.pm >= ts[j]) ? 1 : 0;
        u.x = e; u.a = A + (long)u.pm * ta; u.b = B + (long)e * te + (long)u.pn * tb; return true; }
};

__global__ void __launch_bounds__(NWAVES * 64, 2) mega_fwd(Args args) {
    extern __shared__ __attribute__((aligned(16))) unsigned char lds[];
    Frame F;
    F.lds = (LAS unsigned char*)lds;
    F.MISC = (volatile LAS unsigned*)(F.lds + MISC_OFF);
    F.tid = threadIdx.x; F.lane = F.tid & 63; F.wave = __builtin_amdgcn_readfirstlane(F.tid >> 6);
    F.G = gridDim.x; { const int bx = blockIdx.x; F.vcu = (F.G % 8 == 0) ? (bx % 8) * (F.G / 8) + bx / 8 : bx; }
    F.out = args.out; F.ws = args.ws; F.ctl = (gu32*)(args.ws + WS_CTL);
    unsigned char* ws = args.ws;
    for (int u = F.tid; u < (LDS_BYTES - LDSCTL_OFF) / 4; u += NWAVES * 64) ((LAS unsigned*)(F.lds + LDSCTL_OFF))[u] = 0u;
    __syncthreads();
    XcdBarrier bar; bar.bar = (unsigned*)(F.ctl + CW_BAR); bar.x = 0; bar.st = nullptr;
    if (N_LAUNCHES == 1) bar = xcd_barrier_post((unsigned*)(F.ctl + CW_BAR), F.MISC + 8);
#define GRID_BAR() do { if (N_LAUNCHES == 1) xcd_barrier(bar); } while (0)
    const int lo = args.ph_lo, hi = args.ph_hi;
#define IN(k) (lo <= (k) && (k) < hi)
#define BOTH(k) (IN(k) && IN((k) + 1))
    const int G = F.G, cid = (int)blockIdx.x;
    const char* H = (const char*)(ws + WS_H);
    const float* mod0 = (const float*)(ws + WS_MOD); const float* mod1 = mod0 + 16 * 6144;
    const float* ng = args.in[4];

    if (IN(0)) { p0_prologue(F, args); if (BOTH(0)) GRID_BAR(); }
    if (IN(1)) { p1_norm_expand(F, args); if (BOTH(1)) GRID_BAR(); }
    if (IN(2)) {
        pg8::GemmG g{16, 0, 2048, 2048, 0, 128, 128, 128L * 1024 * 2, 128L * 1024 * 2, 0, 0, nullptr, 0.f};
        OrderMN S{128, 2, G, cid, H, (const char*)(ws + WS_WIN), 256L * 1024 * 2, 256L * 1024 * 2};
        pg8::EpiS5U E{(pg8::bf16_t*)(ws + WS_UA)};
        pg8::gemm_phase<pg8::EpiS5U, OrderMN, true, true>(F.lds + RING_OFF, g, S, E);
        if (BOTH(2)) GRID_BAR();
    }
    if (IN(3)) {
        pg8::GemmG g{8, 0, 1280, 1024, 0, 128, 128, 128L * 640 * 2, 0, 0, 0, nullptr, 0.f};
        OrderS5A S{G, cid, (const char*)(ws + WS_UA), (const char*)(ws + WS_W1)};
        pg8::EpiS5Scan E{(pg8::bf16_t*)(ws + WS_UA), (const float*)(ws + WS_RT + RT_LAMT)};
        if (cid < 128) pg8::gemm_phase<pg8::EpiS5Scan, OrderS5A, false, true>(F.lds + RING_OFF, g, S, E);
        else s5_expand_tw(F, 128);
        if (BOTH(3)) GRID_BAR();
    }
    if (IN(4)) {
        pg8::GemmG g{10, 0, 1280, 1280, 0, 128, 128, 128L * 640 * 2, 128L * 640 * 2, 0, 0, nullptr, 0.f};
        OrderS5B S{G, cid, (const char*)(ws + WS_UA), (const char*)(ws + WS_TW)};
        pg8::EpiS5Y E{(pg8::bf16_t*)(ws + WS_YG)};
        pg8::gemm_phase<pg8::EpiS5Y, OrderS5B, true, true>(F.lds + RING_OFF, g, S, E);
        if (BOTH(4)) GRID_BAR();
    }
    if (IN(5)) {
        pg8::GemmG g{8, 1, 0, 1024, MTOK, 4L * MTOK * 32, 128, 128L * 32, 128L * 512 * 2, 0, 0, nullptr, 0.f};
        OrderMN S{128, 8, G, cid, (const char*)(ws + WS_YG), (const char*)(ws + WS_WOUT), 256L * 32, 256L * 512 * 2};
        pg8::EpiGate<0> E{(pg8::bf16_t*)(ws + WS_YB), 1024, 1.f};
        pg8::gemm_phase<pg8::EpiGate<0>, OrderMN, true, true>(F.lds + RING_OFF, g, S, E);
        if (BOTH(5)) GRID_BAR();
    }
    if (IN(6)) { normres_phase<false, true>(F, args, args.in[0], ng + 1 * 1024, mod0 + 2 * 1024, ng + 2 * 1024, mod0 + 4 * 1024, mod0 + 3 * 1024); if (BOTH(6)) GRID_BAR(); }
    if (IN(7)) {
        pg8::GemmG g{8, 0, 1024, 1024, 0, 128, 128, 128L * 1024, 128L * 1024, 0, 0, (const float*)(ws + WS_SH), W8_DQ};
        OrderMN S{128, 28, G, cid, H, (const char*)(ws + WS_WGU), 256L * 1024, 256L * 1024};
        pg8::EpiGate<1, true> E{(pg8::bf16_t*)(ws + WS_ACT), FF, 1.f};
        pg8::gemm_phase<pg8::EpiGate<1, true>, OrderMN, true, true, 2>(F.lds + RING_OFF, g, S, E);
        if (BOTH(7)) GRID_BAR();
    }
    if (IN(8)) {
        pg8::GemmG g{28, 0, FF, FF, 0, 128, 128, 128L * FF, 128L * FF, 0x79797979, 0x7d7d7d7d, nullptr, 0.f};
        OrderMN S{128, 4, G, cid, (const char*)(ws + WS_ACT), (const char*)(ws + WS_WD), 256L * FF, 256L * FF};
        pg8::EpiBf16 E{(pg8::bf16_t*)(ws + WS_YB), 1024, 0, 0, 1.f, 1.0f / 64.0f};
        pg8::gemm_phase<pg8::EpiBf16, OrderMN, true, true, 1>(F.lds + RING_OFF, g, S, E);
        if (BOTH(8)) GRID_BAR();
    }
    if (IN(9)) { normres_phase<false, false>(F, args, nullptr, ng + 3 * 1024, mod0 + 5 * 1024, ng + 4 * 1024, mod1 + 1 * 1024, mod1 + 0 * 1024); if (BOTH(9)) GRID_BAR(); }
    if (IN(10)) {
        pg8::GemmG g{8, 0, 1024, 1024, 0, 128, 128, 128L * 1024, 128L * 1024, 0, 0, (const float*)(ws + WS_SH), W8_DQ};
        OrderMN S{128, 12, G, cid, H, (const char*)(ws + WS_WQKV), 256L * 1024, 256L * 1024};
        pg8::EpiBf16 E{(pg8::bf16_t*)(ws + WS_Q), 1024, 1024, (size_t)(WS_K - WS_Q) / 2, C2};
        pg8::gemm_phase<pg8::EpiBf16, OrderMN, true, true, 2>(F.lds + RING_OFF, g, S, E);
        if (BOTH(10)) GRID_BAR();
    }
    if (IN(11)) {
        { volatile LAS unsigned* ubox = F.MISC + 12; gu32* actr = F.ctl + CW_ATTCTR + 64 * (cid & 7);
          unsigned nclaim = 0u; if (F.tid == 0) nclaim = __hip_atomic_fetch_add(actr, 1u, RLX_AGENT);
          for (;;) {
              if (F.tid == 0) ubox[0] = nclaim;
              __syncthreads();
              const int uid = (int)ubox[0] * 8 + (cid & 7);
              __syncthreads();
              if (uid >= BATCH * NHEAD * 8) break;
              if (F.tid == 0) nclaim = __hip_atomic_fetch_add(actr, 1u, RLX_AGENT);
              const int qb = 7 - (uid >> 8), bh = uid & 255;
              sba::attn_unit(bh >> 4, bh & 15, qb, (const bf16*)(ws + WS_Q), (const bf16*)(ws + WS_K), (const bf16*)(ws + WS_V), (bf16*)(ws + WS_H), (char*)lds + RING_OFF);
          } }
        if (BOTH(11)) GRID_BAR();
    }
    if (IN(12)) {
        pg8::GemmG g{16, 0, 2048, 2048, 0, 128, 128, 128L * 1024 * 2, 128L * 1024 * 2, 0, 0, nullptr, 0.f};
        OrderMN S{128, 4, G, cid, (const char*)(ws + WS_H), (const char*)(ws + WS_WO), 256L * 1024 * 2, 256L * 1024 * 2};
        pg8::EpiBf16 E{(pg8::bf16_t*)(ws + WS_YB), 1024, 0, 0, 1.f};
        pg8::gemm_phase<pg8::EpiBf16, OrderMN, true, true>(F.lds + RING_OFF, g, S, E);
        if (BOTH(12)) GRID_BAR();
    }
    if (IN(13)) { normres_phase<true, false>(F, args, nullptr, ng + 5 * 1024, mod1 + 2 * 1024, ng + 6 * 1024, mod1 + 4 * 1024, mod1 + 3 * 1024); if (BOTH(13)) GRID_BAR(); }
    if (IN(14)) { p14_slots(F, args); if (BOTH(14)) GRID_BAR(); }
    if (IN(15) || IN(16)) {
        int ts[9];
#pragma unroll
        for (int e = 0; e < 9; ++e) ts[e] = (int)__builtin_amdgcn_readfirstlane(__hip_atomic_load((unsigned*)(ws + WS_RT + RT_TS) + e, RLX_AGENT));
        if (IN(15)) {
            pg8::GemmG g{8, 0, 1024, 1024, 0, 128, 128, 128L * 1024, 128L * 1024, 0, 0, (const float*)(ws + WS_SX), W8_DQ};
            OrderMoE S{28, G, cid, {ts[0], ts[1], ts[2], ts[3], ts[4], ts[5], ts[6], ts[7], ts[8]}, (const char*)(ws + WS_XP), (const char*)(ws + WS_MWGU), 256L * 1024, 256L * 1024, 7168L * 1024};
            pg8::EpiGate<1, true> E{(pg8::bf16_t*)(ws + WS_ACTM), FF, 1.f};
            pg8::gemm_phase<pg8::EpiGate<1, true>, OrderMoE, true, true, 2>(F.lds + RING_OFF, g, S, E);
            if (BOTH(15)) GRID_BAR();
        }
        if (IN(16)) {
            const int mtm = ts[8] < 256 ? ts[8] : 256;
            { pg8::GemmG g{28, 0, FF, FF, 0, 128, 128, 128L * FF, 128L * FF, 0x79797979, 0x7d7d7d7d, nullptr, 0.f};
              OrderMoE S{4, G, cid, {ts[0], ts[1], ts[2], ts[3], ts[4], ts[5], ts[6], ts[7], mtm}, (const char*)(ws + WS_ACTM), (const char*)(ws + WS_MWD), 256L * FF, 256L * FF, 1024L * FF};
              pg8::EpiBf16 E{(pg8::bf16_t*)(ws + WS_YS), 1024, 0, 0, 1.f, 1.0f / 64.0f};
              pg8::gemm_phase<pg8::EpiBf16, OrderMoE, true, true, 1>(F.lds + RING_OFF, g, S, E); }
            { pg8::GemmG g{4, 0, FF, FF, 0, 128, 128, 128L * FF, 128L * FF, 0x79797979, 0x7d7d7d7d, nullptr, 0.f};
              OrderTail S{ts[8] - mtm, G, cid, {ts[0], ts[1], ts[2], ts[3], ts[4], ts[5], ts[6], ts[7], ts[8]}, (const char*)(ws + WS_ACTM), (const char*)(ws + WS_MWD), 256L * FF, 256L * FF, 1024L * FF};
              pg8::EpiF32Slab E{(float*)(ws + WS_SLAB), 1.0f / 64.0f};
              pg8::gemm_phase<pg8::EpiF32Slab, OrderTail, true, true, 1>(F.lds + RING_OFF, g, S, E); }
            if (BOTH(16)) GRID_BAR();
        }
    }
    if (IN(17)) { p17_final(F, args); }
#undef IN
#undef BOTH
#undef GRID_BAR
}

extern "C" void kernel_launch(void* const* d_in, const int* in_sizes, int n_in, void* d_out, int out_size, void* d_ws, size_t ws_size, hipStream_t stream) {
    static int grid = 0;
    if (grid == 0) {
        if (n_in != 23 || out_size != MTOK * DM || ws_size < WS_END) { fprintf(stderr, "kernel_launch: unexpected shapes (n_in %d out %d ws %zu); nothing launched\n", n_in, out_size, ws_size); grid = -1; return; }
        int dev = 0, cus = 0;
        if (hipGetDevice(&dev) != hipSuccess || hipDeviceGetAttribute(&cus, hipDeviceAttributeMultiprocessorCount, dev) != hipSuccess) { grid = -1; return; }
        if (hipFuncSetAttribute((const void*)mega_fwd, hipFuncAttributeMaxDynamicSharedMemorySize, LDS_BYTES) != hipSuccess) { fprintf(stderr, "kernel_launch: hipFuncSetAttribute failed\n"); grid = -1; return; }
        int per_cu = 0;
        if (hipOccupancyMaxActiveBlocksPerMultiprocessor(&per_cu, (const void*)mega_fwd, NWAVES * 64, LDS_BYTES) != hipSuccess || per_cu < 1) fprintf(stderr, "kernel_launch: occupancy query reports %d workgroups per CU\n", per_cu);
        (void)hipGetLastError();
        grid = 256;
        if (cus != 256) fprintf(stderr, "kernel_launch: device reports %d CUs; this kernel is built for 256\n", cus);
    }
    if (grid < 0) return;
    (void)hipMemsetAsync((char*)d_ws + WS_CTL, 0, CTL_ZERO_BYTES, stream);
    Args a{};
    for (int i = 0; i < 23; ++i) a.in[i] = (const float*)d_in[i];
    a.out = (float*)d_out; a.ws = (unsigned char*)d_ws;
    for (int li = 0; li < N_LAUNCHES; ++li) {
        a.ph_lo = (N_LAUNCHES == 1) ? 0 : li; a.ph_hi = (N_LAUNCHES == 1) ? NPH : li + 1; a.li = li; a.pad = 0;
        hipLaunchKernelGGL(mega_fwd, dim3(grid), dim3(NWAVES * 64), LDS_BYTES, stream, a);
    }
}
```

```cpp
#include <hip/hip_runtime.h>
#include <cstdio>
#include <cstdint>

namespace pg8 {
#define PG8_LAS __attribute__((address_space(3)))
typedef unsigned short bf16_t;
typedef short bf16x8 __attribute__((ext_vector_type(8)));
typedef float f32x4 __attribute__((ext_vector_type(4)));
typedef float f32x2 __attribute__((ext_vector_type(2)));
typedef unsigned u32x4 __attribute__((ext_vector_type(4)));
constexpr int BM = 256, BK = 64, HALF = 128, HTB = HALF * BK * 2  , STAGE_BYTES = 8 * HTB, NXCD = 8, WGM = 8;
constexpr int PG8_RS_OFF = STAGE_BYTES + 2048;

__host__ __device__ __forceinline__ int lds_byte(int r, int c) { const int st = (r >> 4) * 2 + (c >> 5), rr = r & 15, cc = c & 31, ob = rr * 64 + cc * 2; return st * 1024 + (ob ^ (((ob >> 9) & 1) << 5)); }
__host__ __device__ __forceinline__ void stage_rc(int b, int& R, int& C) { const int st = b / 1024, sb = b % 1024, swz = sb ^ (((sb >> 9) & 1) << 5); R = (st >> 1) * 16 + swz / 64; C = (st & 1) * 32 + (swz % 64) / 2; }
__host__ __device__ __forceinline__ int perm32(int rho) { const int n = rho >> 4, i = rho & 15; return 8 * (i >> 2) + 4 * n + (i & 3); }

struct Unit { int pm, pn; const char* a; const char* b; int x; };
struct GemmG { int nt; int amode; int lda, ldb  , gm_rows; long kstepA, kstepB, hstepA, hstepB; int sw, sx;   const float* rowscale; float wscale;   };

__device__ __forceinline__ bool order_next(int nM, int nN, int G, int c, int i, int& pm, int& pn) {
    const int nwg = nM * nN; const long L = (long)i * G + c; if (L >= nwg) return false;
    int wgid = (int)L; { const int q = nwg / NXCD, r = nwg % NXCD, xcd = wgid % NXCD, off = wgid / NXCD; wgid = (xcd < r ? xcd * (q + 1) : r * (q + 1) + (xcd - r) * q) + off; }
    const int nig = WGM * nN, gid = wgid / nig, fm = gid * WGM, gsz = (nM - fm) < WGM ? (nM - fm) : WGM;
    pm = __builtin_amdgcn_readfirstlane(fm + ((wgid % nig) % gsz)); pn = __builtin_amdgcn_readfirstlane((wgid % nig) / gsz); return true;
}

__device__ __forceinline__ unsigned cvt_pk_bf16(float lo, float hi) { unsigned r; asm volatile("v_cvt_pk_bf16_f32 %0, %1, %2" : "=v"(r) : "v"(lo), "v"(hi)); return r; }
typedef int v8i __attribute__((ext_vector_type(8)));
typedef int v4i __attribute__((ext_vector_type(4)));
__device__ __forceinline__ float clamp8(float v) { return __builtin_amdgcn_fmed3f(v, -440.f, 440.f); }
__device__ __forceinline__ unsigned cvt4_fp8(float a, float b, float c, float d) { int w = 0; a = clamp8(a); b = clamp8(b); c = clamp8(c); d = clamp8(d); w = __builtin_amdgcn_cvt_pk_fp8_f32(a, b, w, false); w = __builtin_amdgcn_cvt_pk_fp8_f32(c, d, w, true); return (unsigned)w; }
__device__ __forceinline__ v8i cat8(bf16x8 a, bf16x8 b) { return __builtin_shufflevector(__builtin_bit_cast(v4i, a), __builtin_bit_cast(v4i, b), 0, 1, 2, 3, 4, 5, 6, 7); }
__device__ __forceinline__ float fsigmoid(float x) { return __builtin_amdgcn_rcpf(1.0f + __builtin_amdgcn_exp2f(-1.4426950408889634f * x)); }

struct EpiBf16 {
    static constexpr bool PERM = true, AFTER_DRAIN = false;
    bf16_t* O; int ldc; int split_cols; size_t split_stride; float scale0; float oscale = 1.f;
    __device__ __forceinline__ void operator()(const f32x4 (&acc)[2][2][4][2], const Unit& u, int wr, int wc, int fr, int fq) const {
        const int row0 = u.pm * BM + wr * 64 + fr; int colt = u.pn * BM; bf16_t* base = O;
        float sc = oscale; if (split_cols) { const int t = colt / split_cols; base += (size_t)t * split_stride; colt -= t * split_cols; if (t == 0) sc *= scale0; }
        const int col0 = colt + wc * 32 + 8 * fq;
#pragma unroll
        for (int ai = 0; ai < 2; ++ai)
#pragma unroll
            for (int m = 0; m < 4; ++m) { bf16_t* rowp = base + (size_t)(row0 + ai * HALF + m * 16) * ldc + col0;
#pragma unroll
                for (int bj = 0; bj < 2; ++bj) { f32x4 v0 = acc[ai][bj][m][0] * sc, v1 = acc[ai][bj][m][1] * sc;
                    u32x4 w; w.x = cvt_pk_bf16(v0[0], v0[1]); w.y = cvt_pk_bf16(v0[2], v0[3]); w.z = cvt_pk_bf16(v1[0], v1[1]); w.w = cvt_pk_bf16(v1[2], v1[3]);
                    *(u32x4*)(rowp + bj * HALF) = w; } }
    }
    __device__ __forceinline__ void i8(const f32x4 (&acc)[2][2][4][2], const Unit& u, int wr, int wc, int fr, int fq, const PG8_LAS float* rsl, float wscale) const {
        const int row0 = u.pm * BM + wr * 64 + fr; int colt = u.pn * BM; bf16_t* base = O;
        float sc = wscale; if (split_cols) { const int t = colt / split_cols; base += (size_t)t * split_stride; colt -= t * split_cols; if (t == 0) sc *= scale0; }
        const int col0 = colt + wc * 32 + 8 * fq;
#pragma unroll
        for (int ai = 0; ai < 2; ++ai)
#pragma unroll
            for (int m = 0; m < 4; ++m) { bf16_t* rowp = base + (size_t)(row0 + ai * HALF + m * 16) * ldc + col0; const float rs = rsl[ai * HALF + wr * 64 + m * 16 + fr] * sc;
#pragma unroll
                for (int bj = 0; bj < 2; ++bj) { float o[8];
#pragma unroll
                    for (int n = 0; n < 2; ++n)
#pragma unroll
                        for (int i = 0; i < 4; ++i) { const float fv = acc[ai][bj][m][n][i]; o[4 * n + i] = (float)__float_as_int(fv) * rs; }
                    u32x4 w; w.x = cvt_pk_bf16(o[0], o[1]); w.y = cvt_pk_bf16(o[2], o[3]); w.z = cvt_pk_bf16(o[4], o[5]); w.w = cvt_pk_bf16(o[6], o[7]);
                    *(u32x4*)(rowp + bj * HALF) = w; } }
    }
};
struct EpiF32Slab {
    static constexpr bool PERM = true, AFTER_DRAIN = false;
    float* S; float oscale;
    __device__ __forceinline__ void operator()(const f32x4 (&acc)[2][2][4][2], const Unit& u, int wr, int wc, int fr, int fq) const {
        const int row0 = (u.pm - 256) * BM + wr * 64 + fr, col0 = u.pn * BM + wc * 32 + 8 * fq; float* base = S + (size_t)u.x * (2048 * 1024);
#pragma unroll
        for (int ai = 0; ai < 2; ++ai)
#pragma unroll
            for (int m = 0; m < 4; ++m) { float* rowp = base + (size_t)(row0 + ai * HALF + m * 16) * 1024 + col0;
#pragma unroll
                for (int bj = 0; bj < 2; ++bj) { *(f32x4*)(rowp + bj * HALF) = acc[ai][bj][m][0] * oscale; *(f32x4*)(rowp + bj * HALF + 4) = acc[ai][bj][m][1] * oscale; } }
    }
};
template <int ACT, bool F8OUT = false> struct EpiGate {
    static constexpr bool PERM = true, AFTER_DRAIN = false;
    bf16_t* O; int ldc; float oscale;
    __device__ __forceinline__ void operator()(const f32x4 (&acc)[2][2][4][2], const Unit& u, int wr, int wc, int fr, int fq) const {
        const int row0 = u.pm * BM + wr * 64 + fr, col0 = u.pn * HALF + wc * 32 + 8 * fq;
#pragma unroll
        for (int ai = 0; ai < 2; ++ai)
#pragma unroll
            for (int m = 0; m < 4; ++m) { float o[8];
#pragma unroll
                for (int n = 0; n < 2; ++n)
#pragma unroll
                    for (int i = 0; i < 4; ++i) { const float a = acc[ai][0][m][n][i], b = acc[ai][1][m][n][i];
                        o[4 * n + i] = (ACT == 0) ? a * fsigmoid(b) : a * fsigmoid(a) * b; }
                if constexpr (F8OUT) { typedef unsigned u32x2 __attribute__((ext_vector_type(2))); u32x2 w; w.x = cvt4_fp8(o[0] * oscale, o[1] * oscale, o[2] * oscale, o[3] * oscale); w.y = cvt4_fp8(o[4] * oscale, o[5] * oscale, o[6] * oscale, o[7] * oscale);
                    __builtin_nontemporal_store(w, (u32x2*)((unsigned char*)O + (size_t)(row0 + ai * HALF + m * 16) * ldc + col0)); }
                else { u32x4 w; w.x = cvt_pk_bf16(o[0], o[1]); w.y = cvt_pk_bf16(o[2], o[3]); w.z = cvt_pk_bf16(o[4], o[5]); w.w = cvt_pk_bf16(o[6], o[7]);
                    __builtin_nontemporal_store(w, (u32x4*)(O + (size_t)(row0 + ai * HALF + m * 16) * ldc + col0)); } }
    }
    __device__ __forceinline__ void i8(const f32x4 (&acc)[2][2][4][2], const Unit& u, int wr, int wc, int fr, int fq, const PG8_LAS float* rsl, float wscale) const {
        static_assert(ACT == 1, "EpiGate::i8: SwiGLU only");
        const int row0 = u.pm * BM + wr * 64 + fr, col0 = u.pn * HALF + wc * 32 + 8 * fq;
#pragma unroll
        for (int ai = 0; ai < 2; ++ai)
#pragma unroll
            for (int m = 0; m < 4; ++m) { const float sr = rsl[ai * HALF + wr * 64 + m * 16 + fr] * wscale, c1 = -1.4426950408889634f * sr, c2 = sr * sr * oscale; float o[8];
#pragma unroll
                for (int n = 0; n < 2; ++n)
#pragma unroll
                    for (int i = 0; i < 4; ++i) { const float fa = acc[ai][0][m][n][i], fb = acc[ai][1][m][n][i]; const float ia = (float)__float_as_int(fa), ib = (float)__float_as_int(fb);
                        const float r = __builtin_amdgcn_rcpf(1.0f + __builtin_amdgcn_exp2f(ia * c1)); o[4 * n + i] = (ia * ib) * (c2 * r); }
                if constexpr (F8OUT) { typedef unsigned u32x2 __attribute__((ext_vector_type(2))); u32x2 w; w.x = cvt4_fp8(o[0], o[1], o[2], o[3]); w.y = cvt4_fp8(o[4], o[5], o[6], o[7]);
                    __builtin_nontemporal_store(w, (u32x2*)((unsigned char*)O + (size_t)(row0 + ai * HALF + m * 16) * ldc + col0)); }
                else { u32x4 w; w.x = cvt_pk_bf16(o[0], o[1]); w.y = cvt_pk_bf16(o[2], o[3]); w.z = cvt_pk_bf16(o[4], o[5]); w.w = cvt_pk_bf16(o[6], o[7]);
                    __builtin_nontemporal_store(w, (u32x4*)(O + (size_t)(row0 + ai * HALF + m * 16) * ldc + col0)); } }
    }
};
struct EpiS5U {
    static constexpr bool PERM = true, AFTER_DRAIN = false;
    bf16_t* UA;
    __device__ __forceinline__ void operator()(const f32x4 (&acc)[2][2][4][2], const Unit& u, int wr, int wc, int fr, int fq) const {
#pragma unroll
        for (int ai = 0; ai < 2; ++ai)
#pragma unroll
            for (int m = 0; m < 4; ++m) { const int tok = u.pm * BM + ai * HALF + wr * 64 + m * 16 + fr, b = tok >> 11, t = tok & 2047, c = t >> 5, k = t & 31;
#pragma unroll
                for (int bj = 0; bj < 2; ++bj) { const int g = u.pn * 16 + bj * 8 + wc * 2 + (fq >> 1), h0 = (fq & 1) * 8;
                    const f32x4 v0 = acc[ai][bj][m][0], v1 = acc[ai][bj][m][1];
                    u32x4 w; w.x = cvt_pk_bf16(v0[0], v0[1]); w.y = cvt_pk_bf16(v0[2], v0[3]); w.z = cvt_pk_bf16(v1[0], v1[1]); w.w = cvt_pk_bf16(v1[2], v1[3]);
                    *(u32x4*)(UA + ((size_t)(g * 1024 + b * 64 + c) * 640 + k * 16 + h0)) = w; } }
    }
};
struct EpiS5Scan {
    static constexpr bool PERM = false, AFTER_DRAIN = true;
    bf16_t* UA; const float* lamT;
    __device__ __forceinline__ void fused(f32x4 (&acc)[2][2][4][2], const Unit& u, int wr, int wc, int fr, int fq, PG8_LAS unsigned char* lds, int wid, int lane) const {
        PG8_LAS float* S = (PG8_LAS float*)lds;
#pragma unroll
        for (int ai = 0; ai < 2; ++ai)
#pragma unroll
            for (int m = 0; m < 4; ++m)
#pragma unroll
                for (int n = 0; n < 2; ++n) { const int r = ai * HALF + wr * 64 + m * 16 + fr, c = wc * 32 + 16 * n + 4 * fq;
                    *(PG8_LAS f32x4*)(S + r * 128 + c) = acc[ai][0][m][n]; }
        asm volatile("s_waitcnt lgkmcnt(0)" ::: "memory"); __builtin_amdgcn_s_barrier(); asm volatile("" ::: "memory");
        if (wid < 4) {
        const int g = u.x, bl = wid, p = lane;
        const float lr = lamT[(g * 64 + p) * 2], li = lamT[(g * 64 + p) * 2 + 1];
        float sr = 0.f, si = 0.f;
        bf16_t* dst = UA + ((size_t)(g * 1024 + (u.pm * 4 + bl) * 64) * 640 + 512 + p);
        for (int c = 0; c < 64; ++c) {
            const float ar = S[(bl * 64 + c) * 128 + p], aim = S[(bl * 64 + c) * 128 + 64 + p];
            const unsigned pk = cvt_pk_bf16(sr, si);
            dst[(size_t)c * 640] = (bf16_t)(pk & 0xffffu); dst[(size_t)c * 640 + 64] = (bf16_t)(pk >> 16);
            const float nr = lr * sr - li * si + ar, ni = lr * si + li * sr + aim; sr = nr; si = ni;
        } }
    }
};
struct EpiS5Y {
    static constexpr bool PERM = true, AFTER_DRAIN = false;
    bf16_t* Yg;
    __device__ __forceinline__ void operator()(const f32x4 (&acc)[2][2][4][2], const Unit& u, int wr, int wc, int fr, int fq) const {
        const int g = u.x;
#pragma unroll
        for (int ai = 0; ai < 2; ++ai)
#pragma unroll
            for (int m = 0; m < 4; ++m) { const int r = ai * HALF + wr * 64 + m * 16 + fr, b = u.pm * 4 + (r >> 6), c = r & 63;
#pragma unroll
                for (int bj = 0; bj < 2; ++bj) { const int tau = u.pn * 16 + bj * 8 + wc * 2 + (fq >> 1), tok = b * 2048 + c * 32 + tau; float o[8];
#pragma unroll
                    for (int n = 0; n < 2; ++n)
#pragma unroll
                        for (int i = 0; i < 4; ++i) { const float x = acc[ai][bj][m][n][i]; o[4 * n + i] = x * fsigmoid(1.5957691216057308f * (x + 0.044715f * x * x * x)); }
                    u32x4 w; w.x = cvt_pk_bf16(o[0], o[1]); w.y = cvt_pk_bf16(o[2], o[3]); w.z = cvt_pk_bf16(o[4], o[5]); w.w = cvt_pk_bf16(o[6], o[7]);
                    *(u32x4*)(Yg + ((size_t)(g * 32768 + tok) * 16 + (fq & 1) * 8)) = w; } }
    }
};

template <class Epi, class Sched, bool ALIGN_EPI = false, bool SP2 = false, int MODE = 0  >
__device__ __forceinline__ void gemm_phase(PG8_LAS unsigned char* lds, const GemmG g, const Sched& S, const Epi& E) {
    const int tid = threadIdx.x, wid = __builtin_amdgcn_readfirstlane(tid >> 6), lane = tid & 63, wr = wid >> 2, wc = wid & 3, fr = lane & 15, fq = lane >> 4;
    constexpr bool FP8 = (MODE == 1), I8 = (MODE == 2);
    const int nt = g.nt; const int sclw = g.sw, sclx = g.sx;
    unsigned voffA[2], voffB[2];
#pragma unroll
    for (int i = 0; i < 2; ++i) { int R, C; stage_rc(tid * 16 + i * 8192, R, C); const int Rb = Epi::PERM ? ((R & ~31) + perm32(R & 31)) : R;
        voffA[i] = g.amode == 0 ? (unsigned)(R * g.lda + C * 2) : (unsigned)(((C >> 4) * g.gm_rows + R) * 32 + (C & 15) * 2); voffB[i] = (unsigned)(Rb * g.ldb + C * 2); }
    const long kstepA = g.kstepA, kstepB = g.kstepB, hstepA = g.hstepA, hstepB = g.hstepB;
    const unsigned ldsw = (unsigned)wid * 1024u;
    const int aoff = lds_byte(wr * 64 + fr, fq * 8), boff = lds_byte(wc * 32 + fr, fq * 8);
#define PG8_SA(b, h) (((b) * 2 + (h)) * HTB)
#define PG8_SB(b, h) ((4 + (b) * 2 + (h)) * HTB)
#define PG8_STAGE(bufoff, gbase, voff) do { _Pragma("unroll") for (int _i = 0; _i < 2; ++_i) \
        __builtin_amdgcn_global_load_lds((const unsigned*)((const char*)(gbase) + (voff)[_i]), (PG8_LAS unsigned*)(lds + (bufoff) + ldsw + _i * 8192), 16, 0, 0); } while (0)
#define PG8_LDA(dst, b, h) do { if constexpr (FP8) { _Pragma("unroll") for (int m = 0; m < 4; ++m) dst##8[m] = cat8(*(const PG8_LAS bf16x8*)(lds + PG8_SA(b, h) + aoff + m * 2048), *(const PG8_LAS bf16x8*)(lds + PG8_SA(b, h) + aoff + m * 2048 + 1024)); } \
        else { _Pragma("unroll") for (int m = 0; m < 4; ++m) _Pragma("unroll") for (int k = 0; k < 2; ++k) dst[m][k] = *(const PG8_LAS bf16x8*)(lds + PG8_SA(b, h) + aoff + m * 2048 + k * 1024); } } while (0)
#define PG8_LDB(dst, b, h) do { if constexpr (FP8) { _Pragma("unroll") for (int n = 0; n < 2; ++n) dst##8[n] = cat8(*(const PG8_LAS bf16x8*)(lds + PG8_SB(b, h) + boff + n * 2048), *(const PG8_LAS bf16x8*)(lds + PG8_SB(b, h) + boff + n * 2048 + 1024)); } \
        else { _Pragma("unroll") for (int n = 0; n < 2; ++n) _Pragma("unroll") for (int k = 0; k < 2; ++k) dst[n][k] = *(const PG8_LAS bf16x8*)(lds + PG8_SB(b, h) + boff + n * 2048 + k * 1024); } } while (0)
#define PG8_MMA(ai, bj, At, Bt) do { __builtin_amdgcn_s_setprio(1); if constexpr (FP8) { _Pragma("unroll") for (int m = 0; m < 4; ++m) _Pragma("unroll") for (int n = 0; n < 2; ++n) \
        asm volatile("v_mfma_f32_16x16x128_f8f6f4 %0, %1, %2, %0" : "+v"(acc[ai][bj][m][n]) : "v"(Bt##8[n]), "v"(At##8[m])); } else { \
        _Pragma("unroll") for (int m = 0; m < 4; ++m) _Pragma("unroll") for (int n = 0; n < 2; ++n) _Pragma("unroll") for (int k = 0; k < 2; ++k) { \
        if constexpr (I8) acc[ai][bj][m][n] = __builtin_bit_cast(f32x4, __builtin_amdgcn_mfma_i32_16x16x64_i8(__builtin_bit_cast(v4i, Bt[n][k]), __builtin_bit_cast(v4i, At[m][k]), __builtin_bit_cast(v4i, acc[ai][bj][m][n]), 0, 0, 0)); \
        else acc[ai][bj][m][n] = __builtin_amdgcn_mfma_f32_16x16x32_bf16(Bt[n][k], At[m][k], acc[ai][bj][m][n], 0, 0, 0); } } __builtin_amdgcn_s_setprio(0); } while (0)
#define PG8_WAIT_V(n) asm volatile("s_waitcnt vmcnt(" #n ")" ::: "memory")
#define PG8_WAIT_L(n) asm volatile("s_waitcnt lgkmcnt(" #n ")" ::: "memory")
#define PG8_BAR __builtin_amdgcn_s_barrier()
#define PG8_SCHED __builtin_amdgcn_sched_barrier(0)
    Unit cur, nxt; int ui = 0;
    if (!S.next(0, cur)) return;
    f32x4 acc[2][2][4][2];
#pragma unroll
    for (int a = 0; a < 2; ++a)
#pragma unroll
        for (int b = 0; b < 2; ++b)
#pragma unroll
            for (int m = 0; m < 4; ++m)
#pragma unroll
                for (int n = 0; n < 2; ++n) acc[a][b][m][n] = (f32x4){0.f, 0.f, 0.f, 0.f};
    bf16x8 At[4][2], B0[2][2], B1[2][2]; v8i At8[4], B08[2], B18[2];
    const char* cA = cur.a; const char* cB = cur.b;
#define PG8_RS_LOAD(u_, par_) do { if constexpr (I8) { if (wid == 0) __builtin_amdgcn_global_load_lds((const unsigned*)(g.rowscale + (size_t)(u_).pm * BM + lane * 4), (PG8_LAS unsigned*)(lds + PG8_RS_OFF + (par_) * 1024), 16, 0, 0); } } while (0)
    PG8_RS_LOAD(cur, 0);
    if constexpr (SP2) {
        PG8_STAGE(PG8_SB(0, 0), cB, voffB); PG8_STAGE(PG8_SB(0, 1), cB + hstepB, voffB); PG8_STAGE(PG8_SA(0, 0), cA, voffA); PG8_STAGE(PG8_SA(0, 1), cA + hstepA, voffA);
        if (wr == 1) PG8_BAR;
        PG8_WAIT_V(2); PG8_BAR;
        PG8_STAGE(PG8_SB(1, 0), cB + kstepB, voffB); PG8_STAGE(PG8_SA(1, 0), cA + kstepA, voffA); PG8_STAGE(PG8_SB(1, 1), cB + hstepB + kstepB, voffB);
        PG8_WAIT_V(6); PG8_BAR;
    } else {
        PG8_STAGE(PG8_SB(0, 0), cB, voffB); PG8_STAGE(PG8_SA(0, 0), cA, voffA); PG8_STAGE(PG8_SB(0, 1), cB + hstepB, voffB); PG8_STAGE(PG8_SA(0, 1), cA + hstepA, voffA);
        if (wr == 1) PG8_BAR;
        PG8_WAIT_V(4); PG8_BAR;
        PG8_STAGE(PG8_SB(1, 0), cB + kstepB, voffB); PG8_STAGE(PG8_SA(1, 0), cA + kstepA, voffA); PG8_STAGE(PG8_SB(1, 1), cB + hstepB + kstepB, voffB);
        PG8_WAIT_V(6); PG8_BAR;
    }
    for (;;) {
        const bool has_next = S.next(ui + 1, nxt);
        const char* nA = has_next ? nxt.a : cA; const char* nB = has_next ? nxt.b : cB;
#pragma unroll 1
        for (int t = 0; t < nt; t += 2) {
            const bool last = (t == nt - 2);
            const char* a1 = cA + (long)(t + 1) * kstepA;
            const char* a2 = last ? nA : cA + (long)(t + 2) * kstepA; const char* b2 = last ? nB : cB + (long)(t + 2) * kstepB;
            const char* a3 = a2 + kstepA; const char* b3 = b2 + kstepB;
            if constexpr (SP2) {
            PG8_LDB(B0, 0, 0); PG8_LDB(B1, 0, 1); PG8_SCHED; PG8_LDA(At, 0, 0); PG8_STAGE(PG8_SA(1, 1), a1 + hstepA, voffA);
            PG8_WAIT_V(8); PG8_WAIT_L(0); PG8_BAR; PG8_MMA(0, 0, At, B0); PG8_MMA(0, 1, At, B1); PG8_BAR; PG8_SCHED;
            PG8_LDA(At, 0, 1); PG8_STAGE(PG8_SB(0, 0), b2, voffB); PG8_STAGE(PG8_SB(0, 1), b2 + hstepB, voffB); PG8_STAGE(PG8_SA(0, 0), a2, voffA);
            PG8_WAIT_V(8); PG8_WAIT_L(0); PG8_BAR; PG8_MMA(1, 0, At, B0); PG8_MMA(1, 1, At, B1); PG8_BAR; PG8_SCHED;
            PG8_LDB(B0, 1, 0); PG8_LDB(B1, 1, 1); PG8_SCHED; PG8_LDA(At, 1, 0); PG8_STAGE(PG8_SA(0, 1), a2 + hstepA, voffA);
            PG8_WAIT_V(8); PG8_WAIT_L(0); PG8_BAR; PG8_MMA(0, 0, At, B0); PG8_MMA(0, 1, At, B1); PG8_BAR; PG8_SCHED;
            PG8_LDA(At, 1, 1); PG8_STAGE(PG8_SB(1, 0), b3, voffB); PG8_STAGE(PG8_SB(1, 1), b3 + hstepB, voffB); PG8_STAGE(PG8_SA(1, 0), a3, voffA);
            PG8_WAIT_V(8); PG8_WAIT_L(0); PG8_BAR; PG8_MMA(1, 0, At, B0); PG8_MMA(1, 1, At, B1); PG8_BAR; PG8_SCHED;
            } else {
            PG8_LDB(B0, 0, 0); PG8_SCHED; PG8_LDA(At, 0, 0); PG8_STAGE(PG8_SA(1, 1), a1 + hstepA, voffA);
            PG8_WAIT_L(8); PG8_BAR; PG8_WAIT_L(0); PG8_MMA(0, 0, At, B0); PG8_BAR; PG8_SCHED;
            PG8_LDB(B1, 0, 1); PG8_STAGE(PG8_SB(0, 0), b2, voffB);
            PG8_BAR; PG8_WAIT_L(0); PG8_MMA(0, 1, At, B1); PG8_BAR;
            PG8_LDA(At, 0, 1); PG8_STAGE(PG8_SA(0, 0), a2, voffA);
            PG8_BAR; PG8_WAIT_L(0); PG8_MMA(1, 0, At, B0); PG8_BAR; PG8_SCHED;
            PG8_STAGE(PG8_SB(0, 1), b2 + hstepB, voffB);
            PG8_WAIT_V(6); PG8_BAR; PG8_MMA(1, 1, At, B1); PG8_BAR;
            PG8_LDB(B0, 1, 0); PG8_SCHED; PG8_LDA(At, 1, 0); PG8_STAGE(PG8_SA(0, 1), a2 + hstepA, voffA);
            PG8_WAIT_L(8); PG8_BAR; PG8_WAIT_L(0); PG8_MMA(0, 0, At, B0); PG8_BAR; PG8_SCHED;
            PG8_LDB(B1, 1, 1); PG8_STAGE(PG8_SB(1, 0), b3, voffB);
            PG8_BAR; PG8_WAIT_L(0); PG8_MMA(0, 1, At, B1); PG8_BAR;
            PG8_LDA(At, 1, 1); PG8_STAGE(PG8_SA(1, 0), a3, voffA);
            PG8_BAR; PG8_WAIT_L(0); PG8_MMA(1, 0, At, B0); PG8_BAR; PG8_SCHED;
            PG8_STAGE(PG8_SB(1, 1), b3 + hstepB, voffB);
            PG8_WAIT_V(6); PG8_BAR; PG8_MMA(1, 1, At, B1); PG8_BAR;
            }
        }
        if constexpr (ALIGN_EPI) { if (wr == 0) PG8_BAR; }
        if constexpr (FP8) { PG8_SCHED; asm volatile("s_nop 15\n\ts_nop 15" ::: "memory"); PG8_SCHED; }
        if constexpr (I8) { E.i8(acc, cur, wr, wc, fr, fq, (const PG8_LAS float*)(lds + PG8_RS_OFF + (ui & 1) * 1024), g.wscale); }
        else if constexpr (!Epi::AFTER_DRAIN) { E(acc, cur, wr, wc, fr, fq); }
        if (!has_next) break;
#pragma unroll
        for (int a = 0; a < 2; ++a)
#pragma unroll
            for (int b = 0; b < 2; ++b)
#pragma unroll
                for (int m = 0; m < 4; ++m)
#pragma unroll
                    for (int n = 0; n < 2; ++n) acc[a][b][m][n] = (f32x4){0.f, 0.f, 0.f, 0.f};
        cur = nxt; cA = nA; cB = nB; ++ui;
        PG8_RS_LOAD(cur, ui & 1);
        if constexpr (ALIGN_EPI) { if (wr == 1) PG8_BAR; }
    }
    PG8_WAIT_V(0);
    if constexpr (!ALIGN_EPI) { if (wr == 0) PG8_BAR; }
    PG8_BAR;
    if constexpr (Epi::AFTER_DRAIN) { E.fused(acc, cur, wr, wc, fr, fq, lds, wid, lane); }
#undef PG8_RS_LOAD
#undef PG8_SA
#undef PG8_SB
#undef PG8_STAGE
#undef PG8_LDA
#undef PG8_LDB
#undef PG8_MMA
#undef PG8_WAIT_V
#undef PG8_WAIT_L
#undef PG8_BAR
#undef PG8_SCHED
}
}

constexpr int NWAVES = 8;
constexpr int BATCH = 16, SEQ = 2048, DM = 1024, MTOK = BATCH * SEQ;
constexpr int S5G = 32, TC = 32, NCH = SEQ / TC;
constexpr int NHEAD = 16, HD = 64, FF = 3584, NE = 8;
constexpr int NPH = 18;
#ifndef MK_N_LAUNCHES
#define MK_N_LAUNCHES 1
#endif
constexpr int N_LAUNCHES = MK_N_LAUNCHES;
constexpr float NORM_EPS = 1e-6f;
constexpr float W8_CLIP = 5.0f / 32.0f, W8_Q = 127.0f / W8_CLIP, W8_DQ = W8_CLIP / 127.0f;
constexpr float C2 = 0.125f * 1.4426950408889634f;

constexpr size_t MiB = 1u << 20;
constexpr size_t WS_CTL = 0, CTL_ZERO_BYTES = 32768;
constexpr size_t WS_MOD = 1 * MiB;
constexpr size_t WS_RT = 2 * MiB;
constexpr size_t WS_SH = 3 * MiB, WS_SX = 3 * MiB + 256 * 1024;
constexpr size_t RT_E = 0, RT_G = 128 * 1024, RT_SLOT = 256 * 1024, RT_CNT = 512 * 1024, RT_LAMT = 640 * 1024, RT_TS = 700 * 1024;
constexpr size_t WS_WIN = 4 * MiB, WS_WOUT = 5 * MiB, WS_WGU = 7 * MiB, WS_WD = 21 * MiB, WS_WQKV = 28 * MiB, WS_WO = 34 * MiB, WS_MWGU = 36 * MiB, WS_MWD = 148 * MiB;
constexpr size_t WS_W1 = 204 * MiB, WS_KTAB = 212 * MiB;
constexpr size_t WS_XP = 214 * MiB;
constexpr size_t WS_TW = 214 * MiB, WS_UA = 240 * MiB;
constexpr size_t WS_ACTM = 346 * MiB;
constexpr size_t WS_H = 346 * MiB, WS_YB = 410 * MiB, WS_YG = 474 * MiB, WS_ACT = 474 * MiB, WS_Q = 474 * MiB, WS_K = 538 * MiB, WS_V = 602 * MiB;
constexpr size_t WS_SLAB = 214 * MiB;
constexpr size_t WS_YS = 600 * MiB;
constexpr size_t WS_XR = 736 * MiB;
constexpr size_t WS_END = 808 * MiB;
constexpr int XP_ROWS = 67584;
static_assert(WS_XP + (size_t)XP_ROWS * DM <= WS_ACTM && WS_ACTM + (size_t)XP_ROWS * FF <= WS_YS && WS_YS + (size_t)XP_ROWS * DM * 2 <= WS_END, "ws map");
constexpr int CW_TMO = 0, CW_CODE = 1, CW_P0CTR = 64, CW_ATTCTR = 2048, CW_BAR = 4096;
static_assert((CW_BAR + 3456) * 4 <= (int)CTL_ZERO_BYTES && CTL_ZERO_BYTES % 16 == 0, "control words inside the per-call memset");

constexpr int RING_OFF = 0, RING_BYTES = 131072;
constexpr int LDSCTL_OFF = RING_BYTES, MISC_OFF = LDSCTL_OFF + 320;
constexpr int LDS_BYTES = 147456;

#define GAS __attribute__((address_space(1)))
#define LAS __attribute__((address_space(3)))
typedef unsigned short bf16;
typedef unsigned v4u __attribute__((ext_vector_type(4)));
typedef unsigned v2u __attribute__((ext_vector_type(2)));
typedef float f32x4 __attribute__((ext_vector_type(4)));
typedef float f32x16 __attribute__((ext_vector_type(16)));
typedef short bf16x8 __attribute__((ext_vector_type(8)));
typedef short s16x4 __attribute__((ext_vector_type(4)));
typedef GAS unsigned gu32;
#define RLX_AGENT __ATOMIC_RELAXED, __HIP_MEMORY_SCOPE_AGENT
#define LDS_WAIT() asm volatile("s_waitcnt lgkmcnt(0)" ::: "memory")
#define VM_WAIT() asm volatile("s_waitcnt vmcnt(0)" ::: "memory")
__device__ __forceinline__ unsigned f2bf(float f) { unsigned u = __builtin_bit_cast(unsigned, f); return (u + 0x7fffu + ((u >> 16) & 1u)) >> 16; }
__device__ __forceinline__ unsigned pk2(float lo, float hi) { return f2bf(lo) | (f2bf(hi) << 16); }
__device__ __forceinline__ float bf_lo(unsigned w) { return __builtin_bit_cast(float, w << 16); }
__device__ __forceinline__ float bf_hi(unsigned w) { return __builtin_bit_cast(float, w & 0xffff0000u); }

#define XB_TMO      128
#define XB_XCNT(j)  (256  + 64 * (j))
#define XB_XSUB(j)  (1280 + 64 * (j))
#define XB_XGEN(j)  (2304 + 64 * (j))
#define XB_TOP      3328
#define XB_TOPGEN   3392
#define XCD_BAR_WORDS 3456
#define XB_SPIN_CAP (1u << 18)

__device__ __forceinline__ unsigned xb_ld(unsigned* p)              { return __hip_atomic_load(p, __ATOMIC_RELAXED, __HIP_MEMORY_SCOPE_AGENT); }
__device__ __forceinline__ unsigned xb_add(unsigned* p, unsigned v) { return __hip_atomic_fetch_add(p, v, __ATOMIC_RELAXED, __HIP_MEMORY_SCOPE_AGENT); }
__device__ __forceinline__ unsigned xb_xcc_id() { return (unsigned)__builtin_amdgcn_s_getreg((3 << 11) | 20) & 0xFu; }
#define XB_SPIN(cond, bar) do { unsigned _sp = 0; while (cond) { __builtin_amdgcn_s_sleep(1); \
    if ((++_sp & 255u) == 0u) { if (xb_ld(&(bar)[XB_TMO])) break; if (_sp > XB_SPIN_CAP) { atomicAdd(&(bar)[XB_TMO], 1u); break; } } } } while (0)

struct XcdBarrier {
    unsigned* bar; unsigned x;
    volatile LAS unsigned* st;
};

__device__ __forceinline__ XcdBarrier xcd_barrier_post(unsigned* bar, volatile LAS unsigned* st) {
    XcdBarrier b; b.bar = bar; b.x = xb_xcc_id(); b.st = st;
    if (threadIdx.x == 0) (void)xb_add(&bar[XB_XCNT(b.x)], 1u);
    return b;
}
__device__ __forceinline__ void xcd_barrier_complete(unsigned* bar, unsigned x, unsigned& nloc, unsigned& nx) {
    const unsigned G = gridDim.x * gridDim.y * gridDim.z;
    unsigned sum, cnt, mine, sp = 0u;
    for (;;) {
        sum = 0u; cnt = 0u; mine = 0u;
#pragma unroll
        for (unsigned j = 0; j < 16; ++j) { const unsigned c = xb_ld(&bar[XB_XCNT(j)]); sum += c; cnt += (c > 0u) ? 1u : 0u; mine = (j == x) ? c : mine; }
        if (sum == G) break;
        __builtin_amdgcn_s_sleep(1);
        if ((++sp & 255u) == 0u) { if (xb_ld(&bar[XB_TMO])) break; if (sp > XB_SPIN_CAP) { atomicAdd(&bar[XB_TMO], 1u); break; } }
    }
    nloc = mine > 0u ? mine : 1u; nx = cnt > 0u ? cnt : 1u;
}

__device__ __forceinline__ void xcd_barrier(const XcdBarrier& b) {
    asm volatile("s_waitcnt vmcnt(0)" ::: "memory");
    __syncthreads();
    if (threadIdx.x == 0) {
        unsigned* bar = b.bar;
        __builtin_amdgcn_s_waitcnt(0);
        unsigned nloc = b.st[0], nx = b.st[1];
        if (nloc == 0u) { xcd_barrier_complete(bar, b.x, nloc, nx); b.st[0] = nloc; b.st[1] = nx; }
        const unsigned old = xb_add(&bar[XB_XSUB(b.x)], 1u);
        const unsigned gen = old / nloc;
        if (old + 1u == (gen + 1u) * nloc) {
            __builtin_amdgcn_fence(__ATOMIC_RELEASE, "agent");
            asm volatile("s_waitcnt vmcnt(0)" ::: "memory");
            const unsigned og = xb_add(&bar[XB_TOP], 1u);
            const unsigned tg = og / nx;
            if (og + 1u == (tg + 1u) * nx) xb_add(&bar[XB_TOPGEN], 1u);
            else XB_SPIN(xb_ld(&bar[XB_TOPGEN]) == tg, bar);
            __builtin_amdgcn_fence(__ATOMIC_ACQUIRE, "agent");
            xb_add(&bar[XB_XGEN(b.x)], 1u);
            asm volatile("s_waitcnt vmcnt(0)" ::: "memory");
        } else {
            XB_SPIN(xb_ld(&bar[XB_XGEN(b.x)]) == gen, bar);
            __builtin_amdgcn_fence(__ATOMIC_ACQUIRE, "agent");
            asm volatile("s_waitcnt vmcnt(0)" ::: "memory");
        }
    }
    __syncthreads();
}

namespace sba {
constexpr int NW = 8, QBLK = 32, QB = 256, KVBLK = 64, SLOTB = 8192;
constexpr float SBA_EXIT_MASS = 0x1p-48f;
constexpr int NSLOT = 4, LDS_K = 0, LDS_V = NSLOT * SLOTB, LDS_OST = 2 * NSLOT * SLOTB, LDS_FIN = LDS_OST + NW * 4096, LDS_BYTES = LDS_FIN + 16;
typedef __attribute__((address_space(3))) const char* lds_cptr;
typedef short v4i16_t __attribute__((ext_vector_type(4)));
__device__ __forceinline__ void glds16(const void* gsrc, unsigned lds_dst) { unsigned keep;
    asm volatile("s_mov_b32 %0, m0\n\ts_mov_b32 m0, %2\n\ts_nop 0\n\tglobal_load_lds_dwordx4 %1, off\n\ts_mov_b32 m0, %0" : "=&s"(keep) : "v"(gsrc), "s"(lds_dst) : "memory"); }
__device__ __forceinline__ s16x4 vtr(lds_cptr p) { return __builtin_bit_cast(s16x4, __builtin_amdgcn_ds_read_tr16_b64_v4i16((__attribute__((address_space(3))) v4i16_t*)p)); }
__device__ __forceinline__ unsigned cvtpk(float lo, float hi) { typedef float f2 __attribute__((ext_vector_type(2))); typedef __bf16 b2 __attribute__((ext_vector_type(2))); f2 v = {lo, hi}; b2 b = __builtin_convertvector(v, b2); return __builtin_bit_cast(unsigned, b); }
__device__ __forceinline__ int crow(int r, int hi) { return (r & 3) + 8 * (r >> 2) + 4 * hi; }

template <bool MASK> __device__ __forceinline__ void tile(f32x16 (&o)[2], float& Cc, const bf16x8 (&qr)[4], lds_cptr kp, lds_cptr vp, int kq, int hi, bool skip_hi_block) {
    f32x16 p0 = {}, p1 = {};
#pragma unroll
    for (int d0 = 0; d0 < 4; ++d0) {
        const bf16x8 b0 = *(const __attribute__((address_space(3))) bf16x8*)(kp + d0 * 2048);
        const bf16x8 b1 = *(const __attribute__((address_space(3))) bf16x8*)(kp + d0 * 2048 + 512);
        p0 = __builtin_amdgcn_mfma_f32_32x32x16_bf16(b0, qr[d0], p0, 0, 0, 0);
        if (!(MASK && skip_hi_block)) p1 = __builtin_amdgcn_mfma_f32_32x32x16_bf16(b1, qr[d0], p1, 0, 0, 0);
    }
#define SBA_PV(P, kb) do { _Pragma("unroll") for (int s = 0; s < 2; ++s) { v4u pw; pw.x = cvtpk(P[8 * s], P[8 * s + 1]); pw.y = cvtpk(P[8 * s + 2], P[8 * s + 3]); pw.z = cvtpk(P[8 * s + 4], P[8 * s + 5]); pw.w = cvtpk(P[8 * s + 6], P[8 * s + 7]); \
        const bf16x8 pa = __builtin_bit_cast(bf16x8, pw); _Pragma("unroll") for (int d0 = 0; d0 < 2; ++d0) { \
            const s16x4 lo = vtr(vp + d0 * 4096 + (kb) * 2048 + s * 512), hv = vtr(vp + d0 * 4096 + (kb) * 2048 + s * 512 + 256); \
            const bf16x8 vf = (bf16x8){lo[0], lo[1], lo[2], lo[3], hv[0], hv[1], hv[2], hv[3]}; \
            o[d0] = __builtin_amdgcn_mfma_f32_32x32x16_bf16(pa, vf, o[d0], 0, 0, 0); } } } while (0)
    if (!(MASK && skip_hi_block)) {
        float a1 = 1.f;
#pragma unroll
        for (int r = 15; r >= 0; --r) { float rr = __builtin_amdgcn_rcpf(1.0f + __builtin_amdgcn_exp2f(p1[r])); if (MASK) rr = (kq + 32 + r < 0) ? rr : 1.0f; const float n = a1 * rr; p1[r] = a1 - n; a1 = n; }
        const auto s1 = __builtin_amdgcn_permlane32_swap(__float_as_uint(a1), __float_as_uint(a1), false, false);
        const float a1lo = __uint_as_float(s1[0]), a1hi = __uint_as_float(s1[1]);
        const float base1 = hi ? Cc : Cc * a1hi;
        Cc = Cc * a1hi * a1lo;
#pragma unroll
        for (int r = 0; r < 16; ++r) p1[r] *= base1;
        SBA_PV(p1, 1);
        if (__all(Cc < SBA_EXIT_MASS)) return;
    }
    {
        float a0 = 1.f;
#pragma unroll
        for (int r = 15; r >= 0; --r) { float rr = __builtin_amdgcn_rcpf(1.0f + __builtin_amdgcn_exp2f(p0[r])); if (MASK) rr = (kq + r < 0) ? rr : 1.0f; const float n = a0 * rr; p0[r] = a0 - n; a0 = n; }
        const auto s0 = __builtin_amdgcn_permlane32_swap(__float_as_uint(a0), __float_as_uint(a0), false, false);
        const float a0lo = __uint_as_float(s0[0]), a0hi = __uint_as_float(s0[1]);
        const float base0 = hi ? Cc : Cc * a0hi;
        Cc = Cc * a0hi * a0lo;
#pragma unroll
        for (int r = 0; r < 16; ++r) p0[r] *= base0;
        SBA_PV(p0, 0);
    }
#undef SBA_PV
}

#define SBA_WAITBAR(N) asm volatile("s_waitcnt vmcnt(" #N ") lgkmcnt(0)\n\ts_barrier" ::: "memory")
__device__ __forceinline__ void attn_unit(int b, int h, int qb, const bf16* Q, const bf16* K, const bf16* V, bf16* O, char* shm) {
    const int tid = threadIdx.x, lane = tid & 63, r32 = lane & 31, hi = lane >> 5; const int wid = __builtin_amdgcn_readfirstlane(tid >> 6);
    const long rowbase = (long)b * SEQ; const int q0 = qb * QB;
    const bf16* Qw = Q + (rowbase + q0 + wid * QBLK) * DM + h * HD;
    const bf16* Kh = K + rowbase * DM + h * HD; const bf16* Vh = V + rowbase * DM + h * HD;
    const unsigned lds0 = (unsigned)(uintptr_t)shm;
    const bf16* ksrc = Kh + (long)lane * DM + wid * 8;
    const bf16* vsrc = Vh + (long)(16 * (wid & 3) + (lane >> 2)) * DM + (wid >> 2) * 32 + (lane & 3) * 8;
    const unsigned kdst = lds0 + LDS_K + wid * 1024, vdst = lds0 + LDS_V + wid * 1024;
#define SBA_DMA_K(t, slot) glds16(ksrc + (long)(t) * KVBLK * DM, (unsigned)__builtin_amdgcn_readfirstlane(kdst + (slot)))
#define SBA_DMA_V(t, slot) glds16(vsrc + (long)(t) * KVBLK * DM, (unsigned)__builtin_amdgcn_readfirstlane(vdst + (slot)))
    const lds_cptr shm3 = (lds_cptr)shm;
    const int pir = 16 * ((r32 >> 2) & 1) + (r32 & 3) + 4 * (r32 >> 3);
    const lds_cptr kp0 = shm3 + LDS_K + hi * 1024 + pir * 16;
    const lds_cptr vp0 = shm3 + LDS_V + ((lane >> 4) & 1) * 32 + (lane & 3) * 8 + (16 * hi + ((lane & 15) >> 2)) * 64;
    const int NT = 4 * qb + 4, tstart = 4 * qb + (wid >> 1);
    volatile __attribute__((address_space(3))) unsigned* fin = (volatile __attribute__((address_space(3))) unsigned*)(shm3 + LDS_FIN);
    if (tid == 0) fin[0] = 0u;
    { const bf16* qsrc = Qw + (long)(lane >> 3) * DM + (lane & 7) * 8; const unsigned qdst = lds0 + LDS_OST + wid * 4096;
#pragma unroll
      for (int j = 0; j < 4; ++j) glds16(qsrc + (long)(8 * j) * DM, (unsigned)__builtin_amdgcn_readfirstlane(qdst + j * 1024)); }
    SBA_DMA_K(NT - 1, 0); SBA_DMA_V(NT - 1, 0); SBA_DMA_K(NT - 2, SLOTB); SBA_DMA_V(NT - 2, SLOTB);
    bf16x8 qr[4];
    f32x16 o[2]; o[0] = f32x16{}; o[1] = f32x16{};
    float Cc = 1.f;
    const int qpos = q0 + wid * QBLK + r32;
    bool done = false;
    for (int i = 0;; ++i) {
        const int t = NT - 1 - i, so = (i & 3) * SLOTB;
        if (t >= 2) { SBA_DMA_K(t - 2, ((i + 2) & 3) * SLOTB); SBA_DMA_V(t - 2, ((i + 2) & 3) * SLOTB); SBA_WAITBAR(4); }
        else if (t == 1) { SBA_WAITBAR(2); } else { SBA_WAITBAR(0); }
        if (fin[0] == NW) break;
        if (i == 0) {
#pragma unroll
            for (int d0 = 0; d0 < 4; ++d0) qr[d0] = *(const __attribute__((address_space(3))) bf16x8*)(shm3 + LDS_OST + wid * 4096 + r32 * 128 + d0 * 32 + hi * 16); }
        if (t <= tstart && !done) {
            const int kq = t * KVBLK - qpos + 16 * hi;
            if (t == tstart) tile<true>(o, Cc, qr, kp0 + so, vp0 + so, kq, hi, (wid & 1) == 0); else tile<false>(o, Cc, qr, kp0 + so, vp0 + so, kq, hi, false);
            if (__all(Cc < SBA_EXIT_MASS)) { done = true; if (lane == 0) __hip_atomic_fetch_add((__attribute__((address_space(3))) unsigned*)(shm3 + LDS_FIN), 1u, __ATOMIC_RELAXED, __HIP_MEMORY_SCOPE_WORKGROUP); }
        }
        if (t == 0) break;
    }
    bf16* Ow = O + (rowbase + q0 + wid * QBLK) * DM + h * HD;
    { bf16* stg = (bf16*)(shm + LDS_OST) + wid * 2048;
#pragma unroll
      for (int r = 0; r < 16; ++r) { const int orow = crow(r, hi);
#pragma unroll
        for (int d0 = 0; d0 < 2; ++d0) stg[orow * 64 + d0 * 32 + r32] = (bf16)f2bf(o[d0][r]); }
      asm volatile("s_waitcnt lgkmcnt(0)" ::: "memory");
#pragma unroll
      for (int i = 0; i < 4; ++i) { const int row = i * 8 + (lane >> 3), ch = lane & 7; const v4u v = *(const v4u*)(stg + row * 64 + ch * 8); *(v4u*)(Ow + (long)row * DM + ch * 8) = v; } }
    asm volatile("s_waitcnt vmcnt(0) lgkmcnt(0)\n\ts_barrier" ::: "memory");
#undef SBA_DMA_K
#undef SBA_DMA_V
}
}

struct Args { const float* in[23]; float* out; unsigned char* ws; int ph_lo, ph_hi, li, pad; };
struct Frame {
    LAS unsigned char* lds;
    volatile LAS unsigned* MISC;
    gu32* ctl;
    int tid, lane, wave;
    int vcu, G;
    float* out; unsigned char* ws;
};
__device__ __forceinline__ float wave_sum(float v) {
#pragma unroll
    for (int o = 1; o < 64; o <<= 1) v += __shfl_xor(v, o);
    return v;
}
__device__ __forceinline__ void ld_row_f32(const float* p, int lane, float (&v)[16]) {
#pragma unroll
    for (int j = 0; j < 4; ++j) { const f32x4 t = ((const GAS f32x4*)p)[64 * j + lane]; v[4 * j] = t.x; v[4 * j + 1] = t.y; v[4 * j + 2] = t.z; v[4 * j + 3] = t.w; } }
__device__ __forceinline__ void st_row_f32(float* p, int lane, const float (&v)[16]) {
#pragma unroll
    for (int j = 0; j < 4; ++j) ((GAS f32x4*)p)[64 * j + lane] = (f32x4){v[4 * j], v[4 * j + 1], v[4 * j + 2], v[4 * j + 3]}; }
__device__ __forceinline__ void ld_row_bf16(const bf16* p, int lane, float (&v)[16]) {
#pragma unroll
    for (int j = 0; j < 4; ++j) { const v2u t = ((const GAS v2u*)p)[64 * j + lane]; v[4 * j] = bf_lo(t.x); v[4 * j + 1] = bf_hi(t.x); v[4 * j + 2] = bf_lo(t.y); v[4 * j + 3] = bf_hi(t.y); } }
__device__ __forceinline__ void ldraw_f32(const float* p, int lane, f32x4 (&r)[4]) {
#pragma unroll
    for (int j = 0; j < 4; ++j) r[j] = __builtin_nontemporal_load(((const GAS f32x4*)p) + 64 * j + lane); }
__device__ __forceinline__ void ldraw_bf16(const bf16* p, int lane, v2u (&r)[4]) {
#pragma unroll
    for (int j = 0; j < 4; ++j) r[j] = __builtin_nontemporal_load(((const GAS v2u*)p) + 64 * j + lane); }
__device__ __forceinline__ void cvraw_f32(const f32x4 (&r)[4], float (&v)[16]) {
#pragma unroll
    for (int j = 0; j < 4; ++j) { v[4 * j] = r[j].x; v[4 * j + 1] = r[j].y; v[4 * j + 2] = r[j].z; v[4 * j + 3] = r[j].w; } }
__device__ __forceinline__ void cvraw_bf16(const v2u (&r)[4], float (&v)[16]) {
#pragma unroll
    for (int j = 0; j < 4; ++j) { v[4 * j] = bf_lo(r[j].x); v[4 * j + 1] = bf_hi(r[j].x); v[4 * j + 2] = bf_lo(r[j].y); v[4 * j + 3] = bf_hi(r[j].y); } }
__device__ __forceinline__ void st_row_bf16(bf16* p, int lane, const float (&v)[16]) {
#pragma unroll
    for (int j = 0; j < 4; ++j) { v2u t; t.x = pk2(v[4 * j], v[4 * j + 1]); t.y = pk2(v[4 * j + 2], v[4 * j + 3]); ((GAS v2u*)p)[64 * j + lane] = t; } }
__device__ __forceinline__ unsigned pack_i8(float a, float b, float c, float d) {
    const int ia = (int)__builtin_fminf(__builtin_fmaxf(__builtin_rintf(a), -127.f), 127.f), ib = (int)__builtin_fminf(__builtin_fmaxf(__builtin_rintf(b), -127.f), 127.f);
    const int ic = (int)__builtin_fminf(__builtin_fmaxf(__builtin_rintf(c), -127.f), 127.f), id = (int)__builtin_fminf(__builtin_fmaxf(__builtin_rintf(d), -127.f), 127.f);
    return (unsigned)(ia & 255) | ((unsigned)(ib & 255) << 8) | ((unsigned)(ic & 255) << 16) | ((unsigned)(id & 255) << 24); }
__device__ __forceinline__ float wave_max(float v) {
#pragma unroll
    for (int o = 1; o < 64; o <<= 1) v = __builtin_fmaxf(v, __shfl_xor(v, o));
    return v; }
__device__ __forceinline__ float st_row_i8(unsigned char* p, int lane, const float (&v)[16]) {
    float mx = 0.f;
#pragma unroll
    for (int i = 0; i < 16; ++i) mx = __builtin_fmaxf(mx, __builtin_fabsf(v[i]));
    mx = __builtin_fmaxf(wave_max(mx), 1e-20f); const float q = 127.0f / mx;
#pragma unroll
    for (int j = 0; j < 4; ++j) ((GAS unsigned*)p)[64 * j + lane] = pack_i8(q * v[4 * j], q * v[4 * j + 1], q * v[4 * j + 2], q * v[4 * j + 3]);
    return mx * (1.0f / 127.0f); }
__device__ __forceinline__ void st_row_f32_nt(float* p, int lane, const float (&v)[16]) {
#pragma unroll
    for (int j = 0; j < 4; ++j) __builtin_nontemporal_store((f32x4){v[4 * j], v[4 * j + 1], v[4 * j + 2], v[4 * j + 3]}, ((GAS f32x4*)p) + 64 * j + lane); }
__device__ __forceinline__ void st_row_bf16_nt(bf16* p, int lane, const float (&v)[16]) {
#pragma unroll
    for (int j = 0; j < 4; ++j) { v2u t; t.x = pk2(v[4 * j], v[4 * j + 1]); t.y = pk2(v[4 * j + 2], v[4 * j + 3]); __builtin_nontemporal_store(t, ((GAS v2u*)p) + 64 * j + lane); } }
__device__ __forceinline__ float sumsq16(const float (&v)[16]) { float s = 0.f;
#pragma unroll
    for (int i = 0; i < 16; ++i) s += v[i] * v[i];
    return s; }

__device__ __forceinline__ int row_of(int wg, int wave, int k) { return (wg * NWAVES + wave) * 16 + k; }
__device__ __forceinline__ void p0_transpose_item(const float* W, int K, int N, bf16* WT, int k0, int ns, int nd, LAS float* scr, int lane) {
    { f32x4 t_[8];
#pragma unroll
      for (int i = 0; i < 8; ++i) t_[i] = __builtin_nontemporal_load((const GAS f32x4*)(W + (size_t)(k0 + 8 * i + (lane >> 3)) * N + ns + 4 * (lane & 7)));
#pragma unroll
      for (int i = 0; i < 8; ++i) { LAS float* d_ = scr + (8 * i + (lane >> 3)) * 33 + 4 * (lane & 7); d_[0] = t_[i].x; d_[1] = t_[i].y; d_[2] = t_[i].z; d_[3] = t_[i].w; } }
    LDS_WAIT(); asm volatile("" ::: "memory");
    const int c = lane & 7;
#pragma unroll
    for (int j = 0; j < 4; ++j) { const int n = (lane >> 3) + 8 * j; const LAS float* s = scr + (8 * c) * 33 + n;
        v4u o; o.x = pk2(s[0 * 33], s[1 * 33]); o.y = pk2(s[2 * 33], s[3 * 33]); o.z = pk2(s[4 * 33], s[5 * 33]); o.w = pk2(s[6 * 33], s[7 * 33]);
        __builtin_nontemporal_store(o, (GAS v4u*)(WT + (size_t)(nd + n) * K + k0 + 8 * c)); }
    LDS_WAIT(); asm volatile("" ::: "memory");
}
__device__ __forceinline__ void p0_transpose_item8(const float* W, int K, int N, unsigned char* WT, int k0, int ns, int nd, float scl, LAS float* scr, int lane) {
    { f32x4 t_[8];
#pragma unroll
      for (int i = 0; i < 8; ++i) t_[i] = __builtin_nontemporal_load((const GAS f32x4*)(W + (size_t)(k0 + 8 * i + (lane >> 3)) * N + ns + 4 * (lane & 7)));
#pragma unroll
      for (int i = 0; i < 8; ++i) { LAS float* d_ = scr + (8 * i + (lane >> 3)) * 33 + 4 * (lane & 7); d_[0] = t_[i].x; d_[1] = t_[i].y; d_[2] = t_[i].z; d_[3] = t_[i].w; } }
    LDS_WAIT(); asm volatile("" ::: "memory");
    const int c = lane & 3;
#pragma unroll
    for (int j = 0; j < 2; ++j) { const int n = (lane >> 2) + 16 * j; const LAS float* s = scr + (16 * c) * 33 + n;
        v4u o; o.x = pg8::cvt4_fp8(scl * s[0 * 33], scl * s[1 * 33], scl * s[2 * 33], scl * s[3 * 33]); o.y = pg8::cvt4_fp8(scl * s[4 * 33], scl * s[5 * 33], scl * s[6 * 33], scl * s[7 * 33]);
        o.z = pg8::cvt4_fp8(scl * s[8 * 33], scl * s[9 * 33], scl * s[10 * 33], scl * s[11 * 33]); o.w = pg8::cvt4_fp8(scl * s[12 * 33], scl * s[13 * 33], scl * s[14 * 33], scl * s[15 * 33]);
        __builtin_nontemporal_store(o, (GAS v4u*)(WT + (size_t)(nd + n) * K + k0 + 16 * c)); }
    LDS_WAIT(); asm volatile("" ::: "memory");
}
__device__ __forceinline__ void p0_transpose_item_i8(const float* W, int K, int N, unsigned char* WT, int k0, int ns, int nd, float scl, LAS float* scr, int lane) {
    { f32x4 t_[8];
#pragma unroll
      for (int i = 0; i < 8; ++i) t_[i] = __builtin_nontemporal_load((const GAS f32x4*)(W + (size_t)(k0 + 8 * i + (lane >> 3)) * N + ns + 4 * (lane & 7)));
#pragma unroll
      for (int i = 0; i < 8; ++i) { LAS float* d_ = scr + (8 * i + (lane >> 3)) * 33 + 4 * (lane & 7); d_[0] = t_[i].x; d_[1] = t_[i].y; d_[2] = t_[i].z; d_[3] = t_[i].w; } }
    LDS_WAIT(); asm volatile("" ::: "memory");
    const int c = lane & 3;
#pragma unroll
    for (int j = 0; j < 2; ++j) { const int n = (lane >> 2) + 16 * j; const LAS float* s = scr + (16 * c) * 33 + n;
        v4u o; o.x = pack_i8(scl * s[0 * 33], scl * s[1 * 33], scl * s[2 * 33], scl * s[3 * 33]); o.y = pack_i8(scl * s[4 * 33], scl * s[5 * 33], scl * s[6 * 33], scl * s[7 * 33]);
        o.z = pack_i8(scl * s[8 * 33], scl * s[9 * 33], scl * s[10 * 33], scl * s[11 * 33]); o.w = pack_i8(scl * s[12 * 33], scl * s[13 * 33], scl * s[14 * 33], scl * s[15 * 33]);
        __builtin_nontemporal_store(o, (GAS v4u*)(WT + (size_t)(nd + n) * K + k0 + 16 * c)); }
    LDS_WAIT(); asm volatile("" ::: "memory");
}
__device__ __forceinline__ void p0_tri8(const float* W, int K, int N, unsigned char* WT, bool glu, float scl, int r, LAS float* scr, int lane) {
    const int nblk = N / 32, kb = r / nblk, nb = r % nblk, nd = 32 * nb; int ns = nd;
    if (glu) { const int tile = nd >> 8, w = nd & 255; ns = (w < 128) ? tile * 128 + w : (N >> 1) + tile * 128 + (w - 128); }
    p0_transpose_item_i8(W, K, N, WT, 64 * kb, ns, nd, scl, scr, lane);
}
__device__ __forceinline__ void p0_tr8(const float* W, int K, int N, unsigned char* WT, bool glu, float scl, int r, LAS float* scr, int lane) {
    const int nblk = N / 32, kb = r / nblk, nb = r % nblk, nd = 32 * nb; int ns = nd;
    if (glu) { const int tile = nd >> 8, w = nd & 255; ns = (w < 128) ? tile * 128 + w : (N >> 1) + tile * 128 + (w - 128); }
    p0_transpose_item8(W, K, N, WT, 64 * kb, ns, nd, scl, scr, lane);
}
__device__ __forceinline__ void p0_tr(const float* W, int K, int N, bf16* WT, bool glu, int r, LAS float* scr, int lane) {
    const int nblk = N / 32, kb = r / nblk, nb = r % nblk, nd = 32 * nb; int ns = nd;
    if (glu) { const int tile = nd >> 8, w = nd & 255; ns = (w < 128) ? tile * 128 + w : (N >> 1) + tile * 128 + (w - 128); }
    p0_transpose_item(W, K, N, WT, 64 * kb, ns, nd, scr, lane);
}
__device__ __forceinline__ void p0_s5_tables(Frame& F, const Args& AR, int g) {
    const float* lam_re = AR.in[6] + g * 64; const float* lam_im = AR.in[7] + g * 64;
    const float* b_re = AR.in[8] + g * 1024; const float* b_im = AR.in[9] + g * 1024;
    const float* c_re = AR.in[10] + g * 1024; const float* c_im = AR.in[11] + g * 1024;
    const float* dsk = AR.in[12] + g * 16; const float step = expf(AR.in[13][g]);
    LAS float* PW = (LAS float*)(F.lds + RING_OFF);
    LAS float* BB = PW + 64 * 65 * 2;
    LAS float* CC = BB + 64 * 16 * 2;
    const int t = F.tid, p = t & 63, dq = t >> 6;
    { const float lr = lam_re[p] * step, li = lam_im[p] * step;
      for (int i = 0; i < 9; ++i) { const int d = dq * 8 + i; if (i == 8 && dq != 7) break;
          const float mg = expf(lr * (float)d); float sn, cs; sincosf(li * (float)d, &sn, &cs); PW[(p * 65 + d) * 2] = mg * cs; PW[(p * 65 + d) * 2 + 1] = mg * sn; }
      if (dq == 0) { const float mg = expf(lr); float sn, cs; sincosf(li, &sn, &cs); const float lbr = mg * cs, lbi = mg * sn, a = lam_re[p], bq = lam_im[p], den = a * a + bq * bq;
          const float cr = ((lbr - 1.0f) * a + lbi * bq) / den, ci = (lbi * a - (lbr - 1.0f) * bq) / den;
          for (int h = 0; h < 16; ++h) { const float br = b_re[p * 16 + h], bi = b_im[p * 16 + h]; BB[(p * 16 + h) * 2] = cr * br - ci * bi; BB[(p * 16 + h) * 2 + 1] = cr * bi + ci * br; } }
      for (int idx = t; idx < 1024; idx += 512) { CC[idx * 2] = c_re[idx]; CC[idx * 2 + 1] = c_im[idx]; }
    }
    __syncthreads();
    bf16* W1 = (bf16*)(F.ws + WS_W1) + (size_t)g * 128 * 512;
    for (int pi = t; pi < 128 * 64; pi += 512) { const int q = pi >> 6, rem = pi & 63, k = rem >> 1, h0 = (rem & 1) * 8, pp = q & 63; float v[8];
        const float pr = PW[(pp * 65 + 31 - k) * 2], pim = PW[(pp * 65 + 31 - k) * 2 + 1];
#pragma unroll
        for (int j = 0; j < 8; ++j) { const float br = BB[(pp * 16 + h0 + j) * 2], bi = BB[(pp * 16 + h0 + j) * 2 + 1]; v[j] = (q < 64) ? pr * br - pim * bi : pr * bi + pim * br; }
        v4u o; o.x = pk2(v[0], v[1]); o.y = pk2(v[2], v[3]); o.z = pk2(v[4], v[5]); o.w = pk2(v[6], v[7]);
        *(GAS v4u*)(W1 + (size_t)q * 512 + k * 16 + h0) = o; }
    bf16* TW = (bf16*)(F.ws + WS_TW) + (size_t)g * 512 * 640;
    for (int pi = t; pi < 512 * 16; pi += 512) { const int row = pi >> 4, q0 = (pi & 15) * 8, tau = row >> 4, hp = row & 15; float v[8];
#pragma unroll
        for (int j = 0; j < 8; ++j) { const int q = q0 + j, pp = q & 63; const float cr = CC[(hp * 64 + pp) * 2], ci = CC[(hp * 64 + pp) * 2 + 1], pr = PW[(pp * 65 + tau + 1) * 2], pim = PW[(pp * 65 + tau + 1) * 2 + 1];
            v[j] = (q < 64) ? cr * pr - ci * pim : -(cr * pim + ci * pr); }
        v4u o; o.x = pk2(v[0], v[1]); o.y = pk2(v[2], v[3]); o.z = pk2(v[4], v[5]); o.w = pk2(v[6], v[7]);
        *(GAS v4u*)(TW + (size_t)row * 640 + 512 + q0) = o; }
    if (t < 64) { float* lamT = (float*)(F.ws + WS_RT + RT_LAMT) + (g * 64 + t) * 2; lamT[0] = PW[(t * 65 + 32) * 2]; lamT[1] = PW[(t * 65 + 32) * 2 + 1]; }
    { const int hh = t & 255, hp = hh >> 4, h = hh & 15, dh = t >> 8; float acc[16];
#pragma unroll
      for (int i = 0; i < 16; ++i) acc[i] = 0.f;
      for (int pp = 0; pp < 64; ++pp) { const float cr = CC[(hp * 64 + pp) * 2], ci = CC[(hp * 64 + pp) * 2 + 1], br = BB[(pp * 16 + h) * 2], bi = BB[(pp * 16 + h) * 2 + 1];
          const float xr = cr * br - ci * bi, xi = cr * bi + ci * br; const LAS float* pw = PW + (pp * 65 + dh * 16) * 2;
#pragma unroll
          for (int i = 0; i < 16; ++i) acc[i] += pw[2 * i] * xr - pw[2 * i + 1] * xi; }
      if (dh == 0 && hp == h) acc[0] += dsk[h];
      float* Kt = (float*)(F.ws + WS_KTAB) + (size_t)g * 32 * 256;
#pragma unroll
      for (int i = 0; i < 16; ++i) Kt[(dh * 16 + i) * 256 + hh] = acc[i]; }
    __syncthreads();
}
__device__ __forceinline__ void p0_mod_item(Frame& F, const Args& AR, int mi) {
    const int layer = mi / 96, n0 = (mi % 96) * 64;
    LAS float* cT = (LAS float*)(F.lds + RING_OFF);
    LAS float* part = cT + 16384;
    for (int idx = F.tid; idx < 16384; idx += 512) { const int b = idx >> 10, k = idx & 1023; const float v = AR.in[1][idx]; cT[k * 16 + b] = v / (1.0f + expf(-v)); }
    __syncthreads();
    float acc[16];
#pragma unroll
    for (int b = 0; b < 16; ++b) acc[b] = 0.f;
    const float* W = AR.in[2] + (size_t)layer * 1024 * 6144 + n0 + F.lane;
    for (int kb = 0; kb < 128; kb += 8) { float wv[8];
#pragma unroll
        for (int u = 0; u < 8; ++u) wv[u] = __builtin_nontemporal_load(W + (size_t)(F.wave * 128 + kb + u) * 6144);
#pragma unroll
        for (int u = 0; u < 8; ++u) { const LAS f32x4* c4 = (const LAS f32x4*)(cT + (F.wave * 128 + kb + u) * 16);
#pragma unroll
            for (int q = 0; q < 4; ++q) { const f32x4 c = c4[q]; acc[4 * q] += wv[u] * c.x; acc[4 * q + 1] += wv[u] * c.y; acc[4 * q + 2] += wv[u] * c.z; acc[4 * q + 3] += wv[u] * c.w; } } }
#pragma unroll
    for (int b = 0; b < 16; ++b) part[(F.wave * 16 + b) * 64 + F.lane] = acc[b];
    __syncthreads();
    float* mod = (float*)(F.ws + WS_MOD);
    for (int idx = F.tid; idx < 1024; idx += 512) { const int b = idx >> 6, col = idx & 63; float s = AR.in[3][layer * 6144 + n0 + col];
#pragma unroll
        for (int w = 0; w < 8; ++w) s += part[(w * 16 + b) * 64 + col];
        mod[(size_t)(layer * 16 + b) * 6144 + n0 + col] = s; }
    __syncthreads();
}
__device__ __forceinline__ void p0_prologue(Frame& F, const Args& AR) {
    const int bx = blockIdx.x;
    {
    if (bx < 32) p0_s5_tables(F, AR, bx);
    else if (bx < 32 + 192) p0_mod_item(F, AR, bx - 32);
    }
    LAS float* scr = (LAS float*)(F.lds + RING_OFF + F.wave * 16384);
    constexpr int I_IN = 16 * 16, I_OUT = 8 * 64, I_GU = 16 * 224, I_D = 56 * 32, I_QKV = 16 * 96, I_O = 16 * 32;
    constexpr int NITEMS = I_IN + I_OUT + I_GU + I_D + I_QKV + I_O + 8 * I_GU + 8 * I_D;
    {
    gu32* ctr = F.ctl + CW_P0CTR + 64 * (bx & 7);
    for (;;) {
      int it0 = 0; if (F.lane == 0) it0 = (int)__hip_atomic_fetch_add(ctr, 1u, RLX_AGENT);
      it0 = (__builtin_amdgcn_readfirstlane(it0) * 8 + (bx & 7)) * 4; if (it0 >= NITEMS) break;
      for (int it = it0; it < it0 + 4 && it < NITEMS; ++it) {
        int r = it;
        if (r < I_IN) { p0_tr(AR.in[5], 1024, 512, (bf16*)(F.ws + WS_WIN), false, r, scr, F.lane); continue; } r -= I_IN;
        if (r < I_OUT) { p0_tr(AR.in[14], 512, 2048, (bf16*)(F.ws + WS_WOUT), true, r, scr, F.lane); continue; } r -= I_OUT;
        if (r < I_GU) { p0_tri8(AR.in[17], 1024, 7168, (unsigned char*)(F.ws + WS_WGU), true, W8_Q, r, scr, F.lane); continue; } r -= I_GU;
        if (r < I_D) { p0_tr8(AR.in[18], 3584, 1024, (unsigned char*)(F.ws + WS_WD), false, 64.f, r, scr, F.lane); continue; } r -= I_D;
        if (r < I_QKV) { p0_tri8(AR.in[15], 1024, 3072, (unsigned char*)(F.ws + WS_WQKV), false, W8_Q, r, scr, F.lane); continue; } r -= I_QKV;
        if (r < I_O) { p0_tr(AR.in[16], 1024, 1024, (bf16*)(F.ws + WS_WO), false, r, scr, F.lane); continue; } r -= I_O;
        if (r < 8 * I_GU) { const int e = r / I_GU; p0_tri8(AR.in[21] + (size_t)e * 1024 * 7168, 1024, 7168, (unsigned char*)(F.ws + WS_MWGU) + (size_t)e * 7168 * 1024, true, W8_Q, r % I_GU, scr, F.lane); continue; } r -= 8 * I_GU;
        { const int e = r / I_D; p0_tr8(AR.in[22] + (size_t)e * 3584 * 1024, 3584, 1024, (unsigned char*)(F.ws + WS_MWD) + (size_t)e * 1024 * 3584, false, 64.f, r % I_D, scr, F.lane); }
      }
    }
    }
}

__device__ __forceinline__ void p1_norm_expand(Frame& F, const Args& AR) {
    const int row0 = row_of(blockIdx.x, F.wave, 0), b = row0 >> 11;
    const float* mod = (const float*)(F.ws + WS_MOD) + (size_t)(0 * 16 + b) * 6144;
    float gs[16], sh[16];
    { float g0[16], sc[16]; ld_row_f32(AR.in[4] + 0 * 1024, F.lane, g0); ld_row_f32(mod + 1024, F.lane, sc); ld_row_f32(mod, F.lane, sh);
#pragma unroll
      for (int i = 0; i < 16; ++i) gs[i] = g0[i] * (1.0f + sc[i]); }
    bf16* H = (bf16*)(F.ws + WS_H);
    f32x4 xn_[4]; ldraw_f32(AR.in[0] + (size_t)row0 * DM, F.lane, xn_);
    for (int rr = 0; rr < 16; ++rr) { const int row = row0 + rr; float v[16]; cvraw_f32(xn_, v);
        if (rr + 1 < 16) ldraw_f32(AR.in[0] + (size_t)(row + 1) * DM, F.lane, xn_);
        const float rstd = rsqrtf(wave_sum(sumsq16(v)) * (1.0f / DM) + NORM_EPS);
#pragma unroll
        for (int i = 0; i < 16; ++i) v[i] = v[i] * rstd * gs[i] + sh[i];
        st_row_bf16(H + (size_t)row * DM, F.lane, v); }
}
__device__ __forceinline__ void s5_expand_tw(Frame& F, int first_wg) {
    const int nw = (F.G - first_wg) * NWAVES;
    for (int item = ((int)blockIdx.x - first_wg) * NWAVES + F.wave; item < 1024; item += nw) {
      const int g = item >> 5, tau = item & 31; const float* Kt = (const float*)(F.ws + WS_KTAB) + (size_t)g * 32 * 256; bf16* TW = (bf16*)(F.ws + WS_TW) + ((size_t)g * 512 + tau * 16) * 640;
#pragma unroll 8
      for (int it = 0; it < 16; ++it) { const int pi = it * 64 + F.lane, hp = pi >> 6, rem = pi & 63, k = rem >> 1, h0 = (rem & 1) * 8; v4u o = (v4u){0u, 0u, 0u, 0u};
          { const int dd = tau - k; const GAS f32x4* s = (const GAS f32x4*)(Kt + (dd < 0 ? 0 : dd) * 256 + hp * 16 + h0); const f32x4 a = s[0], c = s[1];
            o.x = pk2(a.x, a.y); o.y = pk2(a.z, a.w); o.z = pk2(c.x, c.y); o.w = pk2(c.z, c.w); if (dd < 0) o = (v4u){0u, 0u, 0u, 0u}; }
          *(GAS v4u*)(TW + (size_t)hp * 640 + k * 16 + h0) = o; } }
}
template <bool ROUTE, bool XF32> __device__ __forceinline__ void normres_phase(
    Frame& F, const Args& AR, const float* xold, const float* gA, const float* gate_off, const float* gB, const float* scaleN_off, const float* shiftN_off) {
    const int row0 = row_of(blockIdx.x, F.wave, 0), b = row0 >> 11;
    float cg[16], gbs[16], sh[16];
    { float a[16], c[16]; ld_row_f32(gA, F.lane, a); ld_row_f32(gate_off + (size_t)b * 6144, F.lane, c);
#pragma unroll
      for (int i = 0; i < 16; ++i) cg[i] = a[i] * c[i];
      ld_row_f32(gB, F.lane, a); ld_row_f32(scaleN_off + (size_t)b * 6144, F.lane, c);
#pragma unroll
      for (int i = 0; i < 16; ++i) gbs[i] = a[i] * (1.0f + c[i]);
      ld_row_f32(shiftN_off + (size_t)b * 6144, F.lane, sh); }
    const bf16* YB = (const bf16*)(F.ws + WS_YB); bf16* H = (bf16*)(F.ws + WS_H);
    LAS float* WR = (LAS float*)(F.lds + RING_OFF);
    LAS int* cntl = (LAS int*)(F.lds + RING_OFF + 32768);
    int mycnt[8];
    if (ROUTE) { for (int idx = F.tid; idx < 8192; idx += 512) { const int el = idx >> 3, ee = idx & 7, jj = el >> 8, ll = (el >> 2) & 63, ii = el & 3; WR[(((4 * jj + ii) * 64 + ll) << 3) + ee] = AR.in[19][idx]; } __syncthreads();
#pragma unroll
        for (int e = 0; e < 8; ++e) mycnt[e] = 0; }
    v2u yn_[4], xbn_[4]; f32x4 xfn_[4];
    ldraw_bf16(YB + (size_t)row0 * DM, F.lane, yn_); if (XF32) ldraw_f32(xold + (size_t)row0 * DM, F.lane, xfn_); else ldraw_bf16((const bf16*)(F.ws + WS_XR) + (size_t)row0 * DM, F.lane, xbn_);
    for (int rr = 0; rr < 16; ++rr) { const int row = row0 + rr; float y[16], x[16];
        cvraw_bf16(yn_, y); if (XF32) cvraw_f32(xfn_, x); else cvraw_bf16(xbn_, x);
        if (rr + 1 < 16) { ldraw_bf16(YB + (size_t)(row + 1) * DM, F.lane, yn_); if (XF32) ldraw_f32(xold + (size_t)(row + 1) * DM, F.lane, xfn_); else ldraw_bf16((const bf16*)(F.ws + WS_XR) + (size_t)(row + 1) * DM, F.lane, xbn_); }
        const float rstd = rsqrtf(wave_sum(sumsq16(y)) * (1.0f / DM) + NORM_EPS);
#pragma unroll
        for (int i = 0; i < 16; ++i) x[i] = x[i] + y[i] * rstd * cg[i];
        st_row_bf16_nt((bf16*)(F.ws + WS_XR) + (size_t)row * DM, F.lane, x);
        const float rstd2 = rsqrtf(wave_sum(sumsq16(x)) * (1.0f / DM) + NORM_EPS);
#pragma unroll
        for (int i = 0; i < 16; ++i) y[i] = x[i] * rstd2 * gbs[i] + sh[i];
        { const float rsc = st_row_i8((unsigned char*)H + (size_t)row * DM, F.lane, y); if (F.lane == 0) ((float*)(F.ws + WS_SH))[row] = rsc; }
        if (ROUTE) { float lg[8];
#pragma unroll
            for (int e = 0; e < 8; ++e) lg[e] = 0.f;
#pragma unroll
            for (int j = 0; j < 4; ++j) { asm volatile("" ::: "memory");
#pragma unroll
                for (int i = 0; i < 4; ++i) { const LAS f32x4* w = (const LAS f32x4*)(WR + ((4 * j + i) * 64 + F.lane) * 8); const f32x4 w0 = w[0], w1 = w[1]; const float hv = y[4 * j + i];
                    lg[0] += hv * w0.x; lg[1] += hv * w0.y; lg[2] += hv * w0.z; lg[3] += hv * w0.w; lg[4] += hv * w1.x; lg[5] += hv * w1.y; lg[6] += hv * w1.z; lg[7] += hv * w1.w; } }
            {
              const bool b5 = (F.lane & 32) != 0, b4 = (F.lane & 16) != 0, b3 = (F.lane & 8) != 0; float q4[4], q2[2], q1;
#pragma unroll
              for (int e = 0; e < 4; ++e) { const float keep = b5 ? lg[e + 4] : lg[e], send = b5 ? lg[e] : lg[e + 4]; q4[e] = keep + __shfl_xor(send, 32); }
#pragma unroll
              for (int e = 0; e < 2; ++e) { const float keep = b4 ? q4[e + 2] : q4[e], send = b4 ? q4[e] : q4[e + 2]; q2[e] = keep + __shfl_xor(send, 16); }
              { const float keep = b3 ? q2[1] : q2[0], send = b3 ? q2[0] : q2[1]; q1 = keep + __shfl_xor(send, 8); }
              q1 += __shfl_xor(q1, 4); q1 += __shfl_xor(q1, 2); q1 += __shfl_xor(q1, 1);
#pragma unroll
              for (int e = 0; e < 8; ++e) lg[e] = __builtin_bit_cast(float, __builtin_amdgcn_readlane(__builtin_bit_cast(int, q1), 8 * e)) + AR.in[20][e]; }
            int e1 = 0; float l1 = lg[0];
#pragma unroll
            for (int e = 1; e < 8; ++e) if (lg[e] > l1) { l1 = lg[e]; e1 = e; }
            int e2 = -1; float l2 = -3.0e38f;
#pragma unroll
            for (int e = 0; e < 8; ++e) if (e != e1 && lg[e] > l2) { l2 = lg[e]; e2 = e; }
            const float g1 = 1.0f / (1.0f + expf(l2 - l1));
#pragma unroll
            for (int e = 0; e < 8; ++e) mycnt[e] += (e == e1 || e == e2) ? 1 : 0;
            if (F.lane == 0) { ((int*)(F.ws + WS_RT + RT_E))[row] = e1 | (e2 << 8); ((float*)(F.ws + WS_RT + RT_G))[row] = g1; } }
    }
    if (ROUTE) {
        if (F.lane < 8) { int c = 0;
#pragma unroll
            for (int e = 0; e < 8; ++e) c = (F.lane == e) ? mycnt[e] : c;
            cntl[F.wave * 8 + F.lane] = c; }
        __syncthreads();
        if (F.tid < 8) { int s = 0;
#pragma unroll
            for (int w = 0; w < 8; ++w) s += cntl[w * 8 + F.tid];
            ((int*)(F.ws + WS_RT + RT_CNT))[blockIdx.x * 8 + F.tid] = s; }
        __syncthreads();
    }
}
__device__ __forceinline__ void p14_slots(Frame& F, const Args& AR) {
    LAS int* L = (LAS int*)(F.lds + RING_OFF);
    const int* cnt = (const int*)(F.ws + WS_RT + RT_CNT);
    for (int idx = F.tid; idx < 2048; idx += 512) L[idx] = (int)__hip_atomic_load((unsigned*)cnt + idx, RLX_AGENT);
    __syncthreads();
    if (F.tid < 8) { int tot = 0, pre = 0; for (int w = 0; w < 256; ++w) { const int c = L[w * 8 + F.tid]; if (w < (int)blockIdx.x) pre += c; tot += c; } L[2048 + F.tid] = tot; L[2056 + F.tid] = pre; }
    __syncthreads();
    if (F.tid == 0) { int ts = 0; int* TS = (int*)(F.ws + WS_RT + RT_TS); const bool wr = (blockIdx.x == 0); for (int e = 0; e < 8; ++e) { L[2064 + e] = ts * 256; if (wr) TS[e] = ts; ts += (L[2048 + e] + 255) >> 8; } if (wr) TS[8] = ts; }
    __syncthreads();
    const int myrow = row_of(blockIdx.x, (F.tid >> 4) & 7, F.tid & 15);
    const int* RE = (const int*)(F.ws + WS_RT + RT_E);
    int e1 = 0, e2 = 0;
    if (F.tid < 128) { const int ee = RE[myrow]; e1 = ee & 255; e2 = ee >> 8; }
    if (F.wave < 2) {
#pragma unroll
        for (int e = 0; e < 8; ++e) { const unsigned long long m = __ballot(e1 == e || e2 == e); if (F.lane == 0) { L[2080 + (e * 2 + F.wave) * 2] = (int)(unsigned)m; L[2080 + (e * 2 + F.wave) * 2 + 1] = (int)(unsigned)(m >> 32); } } }
    __syncthreads();
    if (F.tid < 128) {
        int sl[2];
#pragma unroll
        for (int j = 0; j < 2; ++j) { const int e = j ? e2 : e1;
            const unsigned long long m0 = (unsigned long long)(unsigned)L[2080 + (e * 2 + 0) * 2] | ((unsigned long long)(unsigned)L[2080 + (e * 2 + 0) * 2 + 1] << 32);
            const unsigned long long m1 = (unsigned long long)(unsigned)L[2080 + (e * 2 + 1) * 2] | ((unsigned long long)(unsigned)L[2080 + (e * 2 + 1) * 2 + 1] << 32);
            const unsigned long long below = (1ull << F.lane) - 1ull;
            const int rank = (F.wave == 0) ? __popcll(m0 & below) : __popcll(m0) + __popcll(m1 & below);
            sl[j] = L[2064 + e] + L[2056 + e] + rank; }
        L[2112 + F.tid * 2] = sl[0]; L[2112 + F.tid * 2 + 1] = sl[1];
        int* RS = (int*)(F.ws + WS_RT + RT_SLOT); RS[myrow * 2] = sl[0]; RS[myrow * 2 + 1] = sl[1];
    }
    __syncthreads();
    const unsigned char* H = (const unsigned char*)(F.ws + WS_H); unsigned char* XP = (unsigned char*)(F.ws + WS_XP);
    const float* SH = (const float*)(F.ws + WS_SH); float* SX = (float*)(F.ws + WS_SX);
    for (int rr = 0; rr < 16; ++rr) { const int lr = F.wave * 16 + rr; const int s0 = L[2112 + lr * 2], s1 = L[2112 + lr * 2 + 1];
        const int grow = row_of(blockIdx.x, F.wave, rr); const v4u a = __builtin_nontemporal_load(((const GAS v4u*)(H + (size_t)grow * DM)) + F.lane); const float sc = SH[grow];
        ((GAS v4u*)(XP + (size_t)s0 * DM))[F.lane] = a; ((GAS v4u*)(XP + (size_t)s1 * DM))[F.lane] = a;
        if (F.lane == 0) { SX[s0] = sc; SX[s1] = sc; } }
    if (blockIdx.x < 8) { const int e = blockIdx.x, lo = L[2064 + e] + L[2048 + e], hiend = L[2064 + e] + (((L[2048 + e] + 255) >> 8) << 8);
        for (int r = lo + F.wave; r < hiend; r += NWAVES) { ((GAS v4u*)(XP + (size_t)r * DM))[F.lane] = (v4u){0u, 0u, 0u, 0u}; if (F.lane == 0) ((float*)(F.ws + WS_SX))[r] = 0.f; } }
    __syncthreads();
}
__device__ __forceinline__ void p17_final(Frame& F, const Args& AR) {
    const int row0 = row_of(blockIdx.x, F.wave, 0), b = row0 >> 11;
    float cg[16];
    { float a[16], c[16]; ld_row_f32(AR.in[4] + (1 * 4 + 3) * 1024, F.lane, a); ld_row_f32((const float*)(F.ws + WS_MOD) + (size_t)(16 + b) * 6144 + 5 * 1024, F.lane, c);
#pragma unroll
      for (int i = 0; i < 16; ++i) cg[i] = a[i] * c[i]; }
    const bf16* YS = (const bf16*)(F.ws + WS_YS); const int* RS = (const int*)(F.ws + WS_RT + RT_SLOT); const float* RG = (const float*)(F.ws + WS_RT + RT_G);
    int sl0 = 0, sl1 = 0; float gg = 0.f;
    if (F.lane < 16) { sl0 = RS[(row0 + F.lane) * 2]; sl1 = RS[(row0 + F.lane) * 2 + 1]; gg = RG[row0 + F.lane]; }
    const float* SLAB = (const float*)(F.ws + WS_SLAB);
    v2u an_[4], bn_[4], xn_[4];
    int c0 = __builtin_amdgcn_readlane(sl0, 0), c1 = __builtin_amdgcn_readlane(sl1, 0);
    if (c0 < 65536) ldraw_bf16(YS + (size_t)c0 * DM, F.lane, an_); if (c1 < 65536) ldraw_bf16(YS + (size_t)c1 * DM, F.lane, bn_); ldraw_bf16((const bf16*)(F.ws + WS_XR) + (size_t)row0 * DM, F.lane, xn_);
    for (int rr = 0; rr < 16; ++rr) { const int row = row0 + rr; const float g1 = __builtin_bit_cast(float, __builtin_amdgcn_readlane(__builtin_bit_cast(int, gg), rr)), g2 = 1.0f - g1;
        float ya[16], yb[16], x[16]; cvraw_bf16(xn_, x);
        if (c0 < 65536) cvraw_bf16(an_, ya); else {
#pragma unroll
            for (int i = 0; i < 16; ++i) ya[i] = 0.f;
            for (int ks = 0; ks < 7; ++ks) { float t_[16]; ld_row_f32(SLAB + ((size_t)ks * 2048 + (c0 - 65536)) * 1024, F.lane, t_);
#pragma unroll
                for (int i = 0; i < 16; ++i) ya[i] += t_[i]; } }
        if (c1 < 65536) cvraw_bf16(bn_, yb); else {
#pragma unroll
            for (int i = 0; i < 16; ++i) yb[i] = 0.f;
            for (int ks = 0; ks < 7; ++ks) { float t_[16]; ld_row_f32(SLAB + ((size_t)ks * 2048 + (c1 - 65536)) * 1024, F.lane, t_);
#pragma unroll
                for (int i = 0; i < 16; ++i) yb[i] += t_[i]; } }
        if (rr + 1 < 16) { c0 = __builtin_amdgcn_readlane(sl0, rr + 1); c1 = __builtin_amdgcn_readlane(sl1, rr + 1);
            if (c0 < 65536) ldraw_bf16(YS + (size_t)c0 * DM, F.lane, an_); if (c1 < 65536) ldraw_bf16(YS + (size_t)c1 * DM, F.lane, bn_); ldraw_bf16((const bf16*)(F.ws + WS_XR) + (size_t)(row + 1) * DM, F.lane, xn_); }
#pragma unroll
        for (int i = 0; i < 16; ++i) ya[i] = g1 * ya[i] + g2 * yb[i];
        const float rstd = rsqrtf(wave_sum(sumsq16(ya)) * (1.0f / DM) + NORM_EPS);
#pragma unroll
        for (int i = 0; i < 16; ++i) x[i] = x[i] + ya[i] * rstd * cg[i];
        st_row_f32_nt(F.out + (size_t)row * DM, F.lane, x); }
}

struct OrderMN {
    int nM, nN, G, c; const char* A; const char* B; long ta, tb;
    __device__ __forceinline__ bool next(int i, pg8::Unit& u) const { if (!pg8::order_next(nM, nN, G, c, i, u.pm, u.pn)) return false; u.a = A + (long)u.pm * ta; u.b = B + (long)u.pn * tb; u.x = 0; return true; }
};
struct OrderS5A {
    int G, c; const char* UA; const char* W1;
    __device__ __forceinline__ bool next(int i, pg8::Unit& u) const { const int L = i * G + c; if (L >= 128) return false; const int g = L >> 2; u.pm = L & 3; u.pn = 0; u.x = g;
        u.a = UA + ((long)(g * 1024 + u.pm * 256) * 640) * 2; u.b = W1 + (long)g * 128 * 512 * 2; return true; }
};
struct OrderS5B {
    int G, c; const char* UA; const char* TW;
    __device__ __forceinline__ bool next(int i, pg8::Unit& u) const { const int L = i * G + c; if (L >= 256) return false; const int g = L >> 3; u.pm = (L >> 1) & 3; u.pn = L & 1; u.x = g;
        u.a = UA + ((long)(g * 1024 + u.pm * 256) * 640) * 2; u.b = TW + ((long)(g * 512 + u.pn * 256) * 640) * 2; return true; }
};
struct OrderTail {
    int nT, G, c; int ts[9]; const char* A; const char* B; long ta, tb, te;
    __device__ __forceinline__ bool next(int i, pg8::Unit& u) const { const int L = i * G + c; if (L >= nT * 28) return false;
        const int ks = L % 7, t2 = L / 7; u.pn = __builtin_amdgcn_readfirstlane(t2 & 3); u.pm = __builtin_amdgcn_readfirstlane(256 + (t2 >> 2)); u.x = __builtin_amdgcn_readfirstlane(ks); int e = 0;
#pragma unroll
        for (int j = 1; j < 8; ++j) e += (u.pm >= ts[j]) ? 1 : 0;
        u.a = A + (long)u.pm * ta + (long)u.x * 512; u.b = B + (long)e * te + (long)u.pn * tb + (long)u.x * 512; return true; }
};
struct OrderMoE {
    int nN, G, c; int ts[9]; const char* A; const char* B; long ta, tb, te;
    __device__ __forceinline__ bool next(int i, pg8::Unit& u) const { if (!pg8::order_next(ts[8], nN, G, c, i, u.pm, u.pn)) return false; int e = 0;
#pragma unroll
        for (int j = 1; j < 8; ++j) e += (u.pm >= ts[j]) ? 1 : 0;
        u.x = e; u.a = A + (long)u.pm * ta; u.b = B + (long)e * te + (long)u.pn * tb; return true; }
};

__global__ void __launch_bounds__(NWAVES * 64, 2) mega_fwd(Args args) {
    extern __shared__ __attribute__((aligned(16))) unsigned char lds[];
    Frame F;
    F.lds = (LAS unsigned char*)lds;
    F.MISC = (volatile LAS unsigned*)(F.lds + MISC_OFF);
    F.tid = threadIdx.x; F.lane = F.tid & 63; F.wave = __builtin_amdgcn_readfirstlane(F.tid >> 6);
    F.G = gridDim.x; { const int bx = blockIdx.x; F.vcu = (F.G % 8 == 0) ? (bx % 8) * (F.G / 8) + bx / 8 : bx; }
    F.out = args.out; F.ws = args.ws; F.ctl = (gu32*)(args.ws + WS_CTL);
    unsigned char* ws = args.ws;
    for (int u = F.tid; u < (LDS_BYTES - LDSCTL_OFF) / 4; u += NWAVES * 64) ((LAS unsigned*)(F.lds + LDSCTL_OFF))[u] = 0u;
    __syncthreads();
    XcdBarrier bar; bar.bar = (unsigned*)(F.ctl + CW_BAR); bar.x = 0; bar.st = nullptr;
    if (N_LAUNCHES == 1) bar = xcd_barrier_post((unsigned*)(F.ctl + CW_BAR), F.MISC + 8);
#define GRID_BAR() do { if (N_LAUNCHES == 1) xcd_barrier(bar); } while (0)
    const int lo = args.ph_lo, hi = args.ph_hi;
#define IN(k) (lo <= (k) && (k) < hi)
#define BOTH(k) (IN(k) && IN((k) + 1))
    const int G = F.G, cid = (int)blockIdx.x;
    const char* H = (const char*)(ws + WS_H);
    const float* mod0 = (const float*)(ws + WS_MOD); const float* mod1 = mod0 + 16 * 6144;
    const float* ng = args.in[4];

    if (IN(0)) { p0_prologue(F, args); if (BOTH(0)) GRID_BAR(); }
    if (IN(1)) { p1_norm_expand(F, args); if (BOTH(1)) GRID_BAR(); }
    if (IN(2)) {
        pg8::GemmG g{16, 0, 2048, 2048, 0, 128, 128, 128L * 1024 * 2, 128L * 1024 * 2, 0, 0, nullptr, 0.f};
        OrderMN S{128, 2, G, cid, H, (const char*)(ws + WS_WIN), 256L * 1024 * 2, 256L * 1024 * 2};
        pg8::EpiS5U E{(pg8::bf16_t*)(ws + WS_UA)};
        pg8::gemm_phase<pg8::EpiS5U, OrderMN, true, true>(F.lds + RING_OFF, g, S, E);
        if (BOTH(2)) GRID_BAR();
    }
    if (IN(3)) {
        pg8::GemmG g{8, 0, 1280, 1024, 0, 128, 128, 128L * 640 * 2, 0, 0, 0, nullptr, 0.f};
        OrderS5A S{G, cid, (const char*)(ws + WS_UA), (const char*)(ws + WS_W1)};
        pg8::EpiS5Scan E{(pg8::bf16_t*)(ws + WS_UA), (const float*)(ws + WS_RT + RT_LAMT)};
        if (cid < 128) pg8::gemm_phase<pg8::EpiS5Scan, OrderS5A, false, true>(F.lds + RING_OFF, g, S, E);
        else s5_expand_tw(F, 128);
        if (BOTH(3)) GRID_BAR();
    }
    if (IN(4)) {
        pg8::GemmG g{10, 0, 1280, 1280, 0, 128, 128, 128L * 640 * 2, 128L * 640 * 2, 0, 0, nullptr, 0.f};
        OrderS5B S{G, cid, (const char*)(ws + WS_UA), (const char*)(ws + WS_TW)};
        pg8::EpiS5Y E{(pg8::bf16_t*)(ws + WS_YG)};
        pg8::gemm_phase<pg8::EpiS5Y, OrderS5B, true, true>(F.lds + RING_OFF, g, S, E);
        if (BOTH(4)) GRID_BAR();
    }
    if (IN(5)) {
        pg8::GemmG g{8, 1, 0, 1024, MTOK, 4L * MTOK * 32, 128, 128L * 32, 128L * 512 * 2, 0, 0, nullptr, 0.f};
        OrderMN S{128, 8, G, cid, (const char*)(ws + WS_YG), (const char*)(ws + WS_WOUT), 256L * 32, 256L * 512 * 2};
        pg8::EpiGate<0> E{(pg8::bf16_t*)(ws + WS_YB), 1024, 1.f};
        pg8::gemm_phase<pg8::EpiGate<0>, OrderMN, true, true>(F.lds + RING_OFF, g, S, E);
        if (BOTH(5)) GRID_BAR();
    }
    if (IN(6)) { normres_phase<false, true>(F, args, args.in[0], ng + 1 * 1024, mod0 + 2 * 1024, ng + 2 * 1024, mod0 + 4 * 1024, mod0 + 3 * 1024); if (BOTH(6)) GRID_BAR(); }
    if (IN(7)) {
        pg8::GemmG g{8, 0, 1024, 1024, 0, 128, 128, 128L * 1024, 128L * 1024, 0, 0, (const float*)(ws + WS_SH), W8_DQ};
        OrderMN S{128, 28, G, cid, H, (const char*)(ws + WS_WGU), 256L * 1024, 256L * 1024};
        pg8::EpiGate<1, true> E{(pg8::bf16_t*)(ws + WS_ACT), FF, 1.f};
        pg8::gemm_phase<pg8::EpiGate<1, true>, OrderMN, true, true, 2>(F.lds + RING_OFF, g, S, E);
        if (BOTH(7)) GRID_BAR();
    }
    if (IN(8)) {
        pg8::GemmG g{28, 0, FF, FF, 0, 128, 128, 128L * FF, 128L * FF, 0x79797979, 0x7d7d7d7d, nullptr, 0.f};
        OrderMN S{128, 4, G, cid, (const char*)(ws + WS_ACT), (const char*)(ws + WS_WD), 256L * FF, 256L * FF};
        pg8::EpiBf16 E{(pg8::bf16_t*)(ws + WS_YB), 1024, 0, 0, 1.f, 1.0f / 64.0f};
        pg8::gemm_phase<pg8::EpiBf16, OrderMN, true, true, 1>(F.lds + RING_OFF, g, S, E);
        if (BOTH(8)) GRID_BAR();
    }
    if (IN(9)) { normres_phase<false, false>(F, args, nullptr, ng + 3 * 1024, mod0 + 5 * 1024, ng + 4 * 1024, mod1 + 1 * 1024, mod1 + 0 * 1024); if (BOTH(9)) GRID_BAR(); }
    if (IN(10)) {
        pg8::GemmG g{8, 0, 1024, 1024, 0, 128, 128, 128L * 1024, 128L * 1024, 0, 0, (const float*)(ws + WS_SH), W8_DQ};
        OrderMN S{128, 12, G, cid, H, (const char*)(ws + WS_WQKV), 256L * 1024, 256L * 1024};
        pg8::EpiBf16 E{(pg8::bf16_t*)(ws + WS_Q), 1024, 1024, (size_t)(WS_K - WS_Q) / 2, C2};
        pg8::gemm_phase<pg8::EpiBf16, OrderMN, true, true, 2>(F.lds + RING_OFF, g, S, E);
        if (BOTH(10)) GRID_BAR();
    }
    if (IN(11)) {
        { volatile LAS unsigned* ubox = F.MISC + 12; gu32* actr = F.ctl + CW_ATTCTR + 64 * (cid & 7);
          unsigned nclaim = 0u; if (F.tid == 0) nclaim = __hip_atomic_fetch_add(actr, 1u, RLX_AGENT);
          for (;;) {
              if (F.tid == 0) ubox[0] = nclaim;
              __syncthreads();
              const int uid = (int)ubox[0] * 8 + (cid & 7);
              __syncthreads();
              if (uid >= BATCH * NHEAD * 8) break;
              if (F.tid == 0) nclaim = __hip_atomic_fetch_add(actr, 1u, RLX_AGENT);
              const int qb = 7 - (uid >> 8), bh = uid & 255;
              sba::attn_unit(bh >> 4, bh & 15, qb, (const bf16*)(ws + WS_Q), (const bf16*)(ws + WS_K), (const bf16*)(ws + WS_V), (bf16*)(ws + WS_H), (char*)lds + RING_OFF);
          } }
        if (BOTH(11)) GRID_BAR();
    }
    if (IN(12)) {
        pg8::GemmG g{16, 0, 2048, 2048, 0, 128, 128, 128L * 1024 * 2, 128L * 1024 * 2, 0, 0, nullptr, 0.f};
        OrderMN S{128, 4, G, cid, (const char*)(ws + WS_H), (const char*)(ws + WS_WO), 256L * 1024 * 2, 256L * 1024 * 2};
        pg8::EpiBf16 E{(pg8::bf16_t*)(ws + WS_YB), 1024, 0, 0, 1.f};
        pg8::gemm_phase<pg8::EpiBf16, OrderMN, true, true>(F.lds + RING_OFF, g, S, E);
        if (BOTH(12)) GRID_BAR();
    }
    if (IN(13)) { normres_phase<true, false>(F, args, nullptr, ng + 5 * 1024, mod1 + 2 * 1024, ng + 6 * 1024, mod1 + 4 * 1024, mod1 + 3 * 1024); if (BOTH(13)) GRID_BAR(); }
    if (IN(14)) { p14_slots(F, args); if (BOTH(14)) GRID_BAR(); }
    if (IN(15) || IN(16)) {
        int ts[9];
#pragma unroll
        for (int e = 0; e < 9; ++e) ts[e] = (int)__builtin_amdgcn_readfirstlane(__hip_atomic_load((unsigned*)(ws + WS_RT + RT_TS) + e, RLX_AGENT));
        if (IN(15)) {
            pg8::GemmG g{8, 0, 1024, 1024, 0, 128, 128, 128L * 1024, 128L * 1024, 0, 0, (const float*)(ws + WS_SX), W8_DQ};
            OrderMoE S{28, G, cid, {ts[0], ts[1], ts[2], ts[3], ts[4], ts[5], ts[6], ts[7], ts[8]}, (const char*)(ws + WS_XP), (const char*)(ws + WS_MWGU), 256L * 1024, 256L * 1024, 7168L * 1024};
            pg8::EpiGate<1, true> E{(pg8::bf16_t*)(ws + WS_ACTM), FF, 1.f};
            pg8::gemm_phase<pg8::EpiGate<1, true>, OrderMoE, true, true, 2>(F.lds + RING_OFF, g, S, E);
            if (BOTH(15)) GRID_BAR();
        }
        if (IN(16)) {
            const int mtm = ts[8] < 256 ? ts[8] : 256;
            { pg8::GemmG g{28, 0, FF, FF, 0, 128, 128, 128L * FF, 128L * FF, 0x79797979, 0x7d7d7d7d, nullptr, 0.f};
              OrderMoE S{4, G, cid, {ts[0], ts[1], ts[2], ts[3], ts[4], ts[5], ts[6], ts[7], mtm}, (const char*)(ws + WS_ACTM), (const char*)(ws + WS_MWD), 256L * FF, 256L * FF, 1024L * FF};
              pg8::EpiBf16 E{(pg8::bf16_t*)(ws + WS_YS), 1024, 0, 0, 1.f, 1.0f / 64.0f};
              pg8::gemm_phase<pg8::EpiBf16, OrderMoE, true, true, 1>(F.lds + RING_OFF, g, S, E); }
            { pg8::GemmG g{4, 0, FF, FF, 0, 128, 128, 128L * FF, 128L * FF, 0x79797979, 0x7d7d7d7d, nullptr, 0.f};
              OrderTail S{ts[8] - mtm, G, cid, {ts[0], ts[1], ts[2], ts[3], ts[4], ts[5], ts[6], ts[7], ts[8]}, (const char*)(ws + WS_ACTM), (const char*)(ws + WS_MWD), 256L * FF, 256L * FF, 1024L * FF};
              pg8::EpiF32Slab E{(float*)(ws + WS_SLAB), 1.0f / 64.0f};
              pg8::gemm_phase<pg8::EpiF32Slab, OrderTail, true, true, 1>(F.lds + RING_OFF, g, S, E); }
            if (BOTH(16)) GRID_BAR();
        }
    }
    if (IN(17)) { p17_final(F, args); }
#undef IN
#undef BOTH
#undef GRID_BAR
}

extern "C" void kernel_launch(void* const* d_in, const int* in_sizes, int n_in, void* d_out, int out_size, void* d_ws, size_t ws_size, hipStream_t stream) {
    static int grid = 0;
    if (grid == 0) {
        if (n_in != 23 || out_size != MTOK * DM || ws_size < WS_END) { fprintf(stderr, "kernel_launch: unexpected shapes (n_in %d out %d ws %zu); nothing launched\n", n_in, out_size, ws_size); grid = -1; return; }
        int dev = 0, cus = 0;
        if (hipGetDevice(&dev) != hipSuccess || hipDeviceGetAttribute(&cus, hipDeviceAttributeMultiprocessorCount, dev) != hipSuccess) { grid = -1; return; }
        if (hipFuncSetAttribute((const void*)mega_fwd, hipFuncAttributeMaxDynamicSharedMemorySize, LDS_BYTES) != hipSuccess) { fprintf(stderr, "kernel_launch: hipFuncSetAttribute failed\n"); grid = -1; return; }
        int per_cu = 0;
        if (hipOccupancyMaxActiveBlocksPerMultiprocessor(&per_cu, (const void*)mega_fwd, NWAVES * 64, LDS_BYTES) != hipSuccess || per_cu < 1) fprintf(stderr, "kernel_launch: occupancy query reports %d workgroups per CU\n", per_cu);
        (void)hipGetLastError();
        grid = 256;
        if (cus != 256) fprintf(stderr, "kernel_launch: device reports %d CUs; this kernel is built for 256\n", cus);
    }
    if (grid < 0) return;
    (void)hipMemsetAsync((char*)d_ws + WS_CTL, 0, CTL_ZERO_BYTES, stream);
    Args a{};
    for (int i = 0; i < 23; ++i) a.in[i] = (const float*)d_in[i];
    a.out = (float*)d_out; a.ws = (unsigned char*)d_ws;
    for (int li = 0; li < N_LAUNCHES; ++li) {
        a.ph_lo = (N_LAUNCHES == 1) ? 0 : li; a.ph_hi = (N_LAUNCHES == 1) ? NPH : li + 1; a.li = li; a.pad = 0;
        hipLaunchKernelGGL(mega_fwd, dim3(grid), dim3(NWAVES * 64), LDS_BYTES, stream, a);
    }
}
```
